# Optimizing an MI355X kernel written in HIP

```python
import jax
import jax.numpy as jnp
from jax import lax
import numpy as np

D_MODEL = 1024
BATCH = 2
SEQ = 8192
DEPTH = 1

MEM_LEN = 256
EPS = 1e-6

GLA_HEADS = 4
GLA_DK = D_MODEL // 8
GLA_DV = D_MODEL // 4
GLA_GATE_RANK = 16
GLA_GATE_TEMP = 16.0
GLA_CHUNK = 64

DSA_HEADS = 8
DSA_KV_HEADS = 2
DSA_HEAD_DIM = 128
IDX_HEADS = 8
IDX_DIM = 64
IDX_TOPK_MAX = 256
Q_BLOCK = 128

MEM_HEADS = 4
MEM_HEAD_DIM = D_MODEL // 4

N_GROUPS = 4
EXPERTS_PER_GROUP = 4
N_EXPERTS = N_GROUPS * EXPERTS_PER_GROUP
EXPERT_TOPK = 2
D_EXPERT = D_MODEL // 4

N_BRANCH = 3
IN_SPLITS = (
    GLA_HEADS * GLA_DK,
    GLA_HEADS * GLA_DK,
    GLA_HEADS * GLA_DV,
    GLA_HEADS * GLA_DV,
    GLA_GATE_RANK,
    DSA_HEADS * DSA_HEAD_DIM,
    DSA_KV_HEADS * DSA_HEAD_DIM,
    DSA_KV_HEADS * DSA_HEAD_DIM,
    IDX_HEADS * IDX_DIM,
    IDX_DIM,
    IDX_HEADS,
    MEM_HEADS * MEM_HEAD_DIM,
    N_BRANCH * D_MODEL,
)
D_IN = sum(IN_SPLITS)

kernel_name = 'hybrid_gla_dsa_memxattn_hmoe'


def _rmsnorm(x, g):
    xf = x.astype(jnp.float32)
    y = xf * lax.rsqrt(jnp.mean(xf * xf, axis=-1, keepdims=True) + EPS)
    return y.astype(x.dtype) * g


def _split_in(z):
    offs = []
    acc = 0
    for w in IN_SPLITS[:-1]:
        acc += w
        offs.append(acc)
    return jnp.split(z, offs, axis=-1)


def _gla(q, k, v, g_out, a_low, w_a2, b_a2, norm_g):
    B, T = q.shape[:2]
    C = GLA_CHUNK
    N = T // C
    shp_k = (B, N, C, GLA_HEADS, GLA_DK)
    qf = q.astype(jnp.float32).reshape(shp_k) * GLA_DK ** -0.5
    kf = k.astype(jnp.float32).reshape(shp_k)
    vf = v.astype(jnp.float32).reshape(B, N, C, GLA_HEADS, GLA_DV)
    log_a = jax.nn.log_sigmoid((a_low @ w_a2 + b_a2).astype(jnp.float32)) / GLA_GATE_TEMP
    cum = jnp.cumsum(log_a.reshape(shp_k), axis=2)
    last = cum[:, :, -1:]
    q_dec = qf * jnp.exp(cum)
    k_inv = kf * jnp.exp(-cum)
    k_end = kf * jnp.exp(last - cum)
    causal = jnp.tril(jnp.ones((C, C), dtype=bool))
    att = jnp.where(causal, jnp.einsum('bnihd,bnjhd->bnhij', q_dec, k_inv), 0.0)
    o_intra = jnp.einsum('bnhij,bnjhv->bnihv', att, vf)
    upd = jnp.einsum('bnjhd,bnjhv->nbhdv', k_end, vf)
    decay = jnp.exp(last[:, :, 0]).transpose(1, 0, 2, 3)

    def step(state, inp):
        dec, u = inp
        return dec[..., None] * state + u, state

    s0 = jnp.zeros((B, GLA_HEADS, GLA_DK, GLA_DV), jnp.float32)
    _, s_prev = lax.scan(step, s0, (decay, upd))
    o_inter = jnp.einsum('bnihd,nbhdv->bnihv', q_dec, s_prev)
    o = (o_intra + o_inter).reshape(B, T, GLA_HEADS, GLA_DV)
    o = _rmsnorm(o, norm_g.astype(jnp.float32)).reshape(B, T, GLA_HEADS * GLA_DV)
    return (o * jax.nn.silu(g_out.astype(jnp.float32))).astype(q.dtype)


def _dsa(q, k, v, q_idx, k_idx, w_idx, q_gain, k_gain, kidx_gain):
    B, T = q.shape[:2]
    topk = min(IDX_TOPK_MAX, T // 4)
    grp = DSA_HEADS // DSA_KV_HEADS
    q = _rmsnorm(q.reshape(B, T, DSA_HEADS, DSA_HEAD_DIM), q_gain) * DSA_HEAD_DIM ** -0.5
    k = _rmsnorm(k.reshape(B, T, DSA_KV_HEADS, DSA_HEAD_DIM), k_gain)
    v = v.reshape(B, T, DSA_KV_HEADS, DSA_HEAD_DIM)
    q_idx = q_idx.reshape(B, T, IDX_HEADS, IDX_DIM)
    k_idx = _rmsnorm(k_idx, kidx_gain)
    w_idx = w_idx * (IDX_HEADS ** -0.5 * IDX_DIM ** -0.5)
    key_pos = jnp.arange(T)

    def block(i):
        start = i * Q_BLOCK
        qb = lax.dynamic_slice_in_dim(q, start, Q_BLOCK, axis=1)
        qib = lax.dynamic_slice_in_dim(q_idx, start, Q_BLOCK, axis=1)
        wb = lax.dynamic_slice_in_dim(w_idx, start, Q_BLOCK, axis=1)
        qpos = start + jnp.arange(Q_BLOCK)
        rel = jax.nn.relu(jnp.einsum('bqhd,bsd->bqhs', qib, k_idx).astype(jnp.float32))
        score = jnp.einsum('bqh,bqhs->bqs', wb.astype(jnp.float32), rel)
        allowed = key_pos[None, :] <= qpos[:, None]
        score = jnp.where(allowed, score, -jnp.inf)
        _, idx = lax.top_k(score, topk)
        valid = idx <= qpos[None, :, None]
        kg = jax.vmap(lambda kk, ii: kk[ii])(k, idx)
        vg = jax.vmap(lambda vv, ii: vv[ii])(v, idx)
        qg = qb.reshape(B, Q_BLOCK, DSA_KV_HEADS, grp, DSA_HEAD_DIM)
        logits = jnp.einsum('bqgrd,bqkgd->bqgrk', qg, kg).astype(jnp.float32)
        logits = jnp.where(valid[:, :, None, None, :], logits, -jnp.inf)
        p = jax.nn.softmax(logits, axis=-1).astype(v.dtype)
        o = jnp.einsum('bqgrk,bqkgd->bqgrd', p, vg)
        return o.reshape(B, Q_BLOCK, DSA_HEADS * DSA_HEAD_DIM)

    out = lax.map(block, jnp.arange(T // Q_BLOCK))
    return out.transpose(1, 0, 2, 3).reshape(B, T, DSA_HEADS * DSA_HEAD_DIM)


def _memory_attn(q, mem_h, w_kv, q_gain, k_gain):
    B, T = q.shape[:2]
    M = mem_h.shape[1]
    q = _rmsnorm(q.reshape(B, T, MEM_HEADS, MEM_HEAD_DIM), q_gain) * MEM_HEAD_DIM ** -0.5
    kv = (mem_h @ w_kv).reshape(B, M, 2, MEM_HEADS, MEM_HEAD_DIM)
    k = _rmsnorm(kv[:, :, 0], k_gain)
    v = kv[:, :, 1]
    logits = jnp.einsum('bthd,bmhd->bhtm', q, k).astype(jnp.float32)
    p = jax.nn.softmax(logits, axis=-1).astype(v.dtype)
    o = jnp.einsum('bhtm,bmhd->bthd', p, v)
    return o.reshape(B, T, MEM_HEADS * MEM_HEAD_DIM)


def _hier_moe(h, w_r1, b_r1, w_r2, b_r2, w_gate, w_up, w_down):
    B, T, D = h.shape
    hf = h.reshape(B * T, D)
    g_logits = (hf @ w_r1 + b_r1).astype(jnp.float32)
    g_prob = jax.nn.softmax(g_logits, axis=-1)
    g_sel = jnp.argmax(g_logits, axis=-1)
    g_w = jnp.take_along_axis(g_prob, g_sel[:, None], axis=-1)
    e_logits = (hf @ w_r2 + b_r2).astype(jnp.float32).reshape(-1, N_GROUPS, EXPERTS_PER_GROUP)
    e_logits = jnp.take_along_axis(e_logits, g_sel[:, None, None], axis=1)[:, 0]
    e_prob = jax.nn.softmax(e_logits, axis=-1)
    top_p, top_i = lax.top_k(e_prob, EXPERT_TOPK)
    top_p = top_p / jnp.sum(top_p, axis=-1, keepdims=True)
    expert_id = g_sel[:, None] * EXPERTS_PER_GROUP + top_i
    combine = jnp.sum(jax.nn.one_hot(expert_id, N_EXPERTS, dtype=jnp.float32)
                      * (g_w * top_p)[..., None], axis=1)
    hid = jax.nn.silu(jnp.einsum('nd,edf->nef', hf, w_gate)) * jnp.einsum('nd,edf->nef', hf, w_up)
    hid = hid * combine[..., None].astype(hid.dtype)
    out = jnp.einsum('nef,efd->nd', hid, w_down)
    return out.reshape(B, T, D)


def setup_inputs(seed: int = 0) -> dict:
    key = jax.random.key(seed)
    ks = iter(jax.random.split(key, 40))
    L = DEPTH

    def w(shape, fan_in):
        return jax.random.normal(next(ks), shape, jnp.float32) * fan_in ** -0.5

    def gain(shape):
        return 1.0 + 0.02 * jax.random.normal(next(ks), shape, jnp.float32)

    def bias(shape, s=0.01):
        return s * jax.random.normal(next(ks), shape, jnp.float32)

    return {
        'x': jax.random.normal(next(ks), (BATCH, SEQ, D_MODEL), jnp.float32),
        'mem': jax.random.normal(next(ks), (BATCH, MEM_LEN, D_MODEL), jnp.float32),
        'g_mix': gain((L, D_MODEL)),
        'g_mem': gain((L, D_MODEL)),
        'w_in': w((L, D_MODEL, D_IN), D_MODEL),
        'w_gla_a2': w((L, GLA_GATE_RANK, GLA_HEADS * GLA_DK), GLA_GATE_RANK),
        'b_gla_a2': bias((L, GLA_HEADS * GLA_DK), 0.1),
        'gla_norm': gain((L, GLA_DV)),
        'w_mem_kv': w((L, D_MODEL, 2 * MEM_HEADS * MEM_HEAD_DIM), D_MODEL),
        'dsa_q_norm': gain((L, DSA_HEAD_DIM)),
        'dsa_k_norm': gain((L, DSA_HEAD_DIM)),
        'idx_k_norm': gain((L, IDX_DIM)),
        'mem_q_norm': gain((L, MEM_HEAD_DIM)),
        'mem_k_norm': gain((L, MEM_HEAD_DIM)),
        'b_gate': bias((L, N_BRANCH * D_MODEL), 0.1),
        'w_o_gla': w((L, GLA_HEADS * GLA_DV, D_MODEL), GLA_HEADS * GLA_DV),
        'w_o_dsa': w((L, DSA_HEADS * DSA_HEAD_DIM, D_MODEL), DSA_HEADS * DSA_HEAD_DIM),
        'w_o_mem': w((L, MEM_HEADS * MEM_HEAD_DIM, D_MODEL), MEM_HEADS * MEM_HEAD_DIM),
        'w_out': w((L, D_MODEL, D_MODEL), D_MODEL),
        'g_ffn': gain((L, D_MODEL)),
        'w_r1': w((L, D_MODEL, N_GROUPS), D_MODEL),
        'b_r1': bias((L, N_GROUPS)),
        'w_r2': w((L, D_MODEL, N_EXPERTS), D_MODEL),
        'b_r2': bias((L, N_EXPERTS)),
        'w_gate': w((L, N_EXPERTS, D_MODEL, D_EXPERT), D_MODEL),
        'w_up': w((L, N_EXPERTS, D_MODEL, D_EXPERT), D_MODEL),
        'w_down': w((L, N_EXPERTS, D_EXPERT, D_MODEL), D_EXPERT),
    }


def reference(x, mem, g_mix, g_mem, w_in, w_gla_a2, b_gla_a2, gla_norm, w_mem_kv,
              dsa_q_norm, dsa_k_norm, idx_k_norm, mem_q_norm, mem_k_norm, b_gate,
              w_o_gla, w_o_dsa, w_o_mem, w_out, g_ffn, w_r1, b_r1, w_r2, b_r2,
              w_gate, w_up, w_down):
    B, T, D = x.shape
    for l in range(DEPTH):
        h = _rmsnorm(x, g_mix[l])
        (gq, gk, gv, gg, ga, dq, dk, dv, iq, ik, iw, mq, gates) = _split_in(h @ w_in[l])
        o_gla = _gla(gq, gk, gv, gg, ga, w_gla_a2[l], b_gla_a2[l], gla_norm[l])
        o_dsa = _dsa(dq, dk, dv, iq, ik, iw, dsa_q_norm[l], dsa_k_norm[l], idx_k_norm[l])
        mem_h = _rmsnorm(mem, g_mem[l])
        o_mem = _memory_attn(mq, mem_h, w_mem_kv[l], mem_q_norm[l], mem_k_norm[l])
        gate = jax.nn.sigmoid((gates + b_gate[l]).astype(jnp.float32)).astype(x.dtype)
        gate = gate.reshape(B, T, N_BRANCH, D)
        merged = (gate[:, :, 0] * (o_gla @ w_o_gla[l])
                  + gate[:, :, 1] * (o_dsa @ w_o_dsa[l])
                  + gate[:, :, 2] * (o_mem @ w_o_mem[l]))
        x = x + merged @ w_out[l]
        x = x + _hier_moe(_rmsnorm(x, g_ffn[l]), w_r1[l], b_r1[l], w_r2[l], b_r2[l],
                          w_gate[l], w_up[l], w_down[l])
    return x
```

```cpp
#include <hip/hip_runtime.h>
#include <cstdio>
#include <cstdint>

#ifndef MK_N_LAUNCHES
#define MK_N_LAUNCHES 1
#endif

namespace pg8 {
#define PG8_LAS __attribute__((address_space(3)))
typedef unsigned short bf16_t;
typedef short bf16x8 __attribute__((ext_vector_type(8)));
typedef float f32x4 __attribute__((ext_vector_type(4)));
typedef unsigned u32x4 __attribute__((ext_vector_type(4)));
constexpr int BM = 256, BK = 64, HALF = 128, HTB = HALF * BK * 2, STAGE_BYTES = 8 * HTB, NXCD = 8, WGM = 8;

__host__ __device__ __forceinline__ int lds_byte(int r, int c) { const int st = (r >> 4) * 2 + (c >> 5), rr = r & 15, cc = c & 31, ob = rr * 64 + cc * 2; return st * 1024 + (ob ^ (((ob >> 9) & 1) << 5)); }
__host__ __device__ __forceinline__ void stage_rc(int b, int& R, int& C) { const int st = b / 1024, sb = b % 1024, swz = sb ^ (((sb >> 9) & 1) << 5); R = (st >> 1) * 16 + swz / 64; C = (st & 1) * 32 + (swz % 64) / 2; }
__host__ __device__ __forceinline__ int perm32(int rho) { const int n = rho >> 4, i = rho & 15; return 8 * (i >> 2) + 4 * n + (i & 3); }

struct Unit { int pm, pn, aux; };
struct Gemm { const bf16_t* A; const bf16_t* Bt; int K; };

struct StaticOrder {
    int nM, nN, nwg, G, c;
    __host__ __device__ void init(int M, int N, int G_, int c_) { nM = M / BM; nN = N / BM; nwg = nM * nN; G = G_; c = c_; }
    __host__ __device__ bool next(int i, Unit& u) const {
        const long L = (long)i * G + c; if (L >= nwg) return false;
        int wgid = (int)L; { const int q = nwg / NXCD, r = nwg % NXCD, xcd = wgid % NXCD, off = wgid / NXCD; wgid = (xcd < r ? xcd * (q + 1) : r * (q + 1) + (xcd - r) * q) + off; }
        const int nig = WGM * nN, gid = wgid / nig, fm = gid * WGM, gsz = (nM - fm) < WGM ? (nM - fm) : WGM;
        u.pm = fm + ((wgid % nig) % gsz); u.pn = (wgid % nig) / gsz; u.aux = 0; return true;
    }
};

__device__ __forceinline__ unsigned cvt_pk_bf16(float lo, float hi) { unsigned r; asm volatile("v_cvt_pk_bf16_f32 %0, %1, %2" : "=v"(r) : "v"(lo), "v"(hi)); return r; }
__device__ __forceinline__ unsigned cvt_pk_f16(float lo, float hi) { typedef _Float16 h2 __attribute__((ext_vector_type(2))); h2 v = {(_Float16)lo, (_Float16)hi}; return __builtin_bit_cast(unsigned, v); }

template <class Epi, class Sched, bool ALIGN_EPI, bool GATHER = false>
__device__ __forceinline__ void gemm_phase(PG8_LAS unsigned char* lds, const Gemm g, const Sched& S, const Epi& E, const int* rowtab = nullptr) {
    int tid_ = threadIdx.x; asm volatile("" : "+v"(tid_));
    const int tid = tid_, wid = __builtin_amdgcn_readfirstlane(tid >> 6), lane = tid & 63, wr = wid >> 2, wc = wid & 3, fr = lane & 15, fq = lane >> 4;
    const int K = g.K, nt = K / BK;
    unsigned voffA[2], voffB[2]; int RA[2], CA[2];
#pragma unroll
    for (int i = 0; i < 2; ++i) { int R, C; stage_rc(tid * 16 + i * 8192, R, C); const int Rb = Epi::PERM ? ((R & ~31) + perm32(R & 31)) : R;
        voffA[i] = (unsigned)(R * K + C) * 2u; voffB[i] = (unsigned)(Rb * K + C) * 2u; RA[i] = R; CA[i] = C; }
    const size_t kstep = (size_t)(BK * 2);
    const size_t hstep = (size_t)HALF * K * 2;
    const size_t tstep = 2 * hstep;
    const unsigned ldsw = (unsigned)wid * 1024u;
    const int aoff = lds_byte(wr * 64 + fr, fq * 8), boff = lds_byte(wc * 32 + fr, fq * 8);
#define PG8_SA(b, h) (((b) * 2 + (h)) * HTB)
#define PG8_SB(b, h) ((4 + (b) * 2 + (h)) * HTB)
#define PG8_STAGE(bufoff, gbase, voff) do { _Pragma("unroll") for (int _i = 0; _i < 2; ++_i) \
        __builtin_amdgcn_global_load_lds((const unsigned*)((const char*)(gbase) + (voff)[_i]), (PG8_LAS unsigned*)(lds + (bufoff) + ldsw + _i * 8192), 16, 0, 0); } while (0)
#define PG8_LDA(dst, b, h) do { _Pragma("unroll") for (int m = 0; m < 4; ++m) _Pragma("unroll") for (int k = 0; k < 2; ++k) dst[m][k] = *(const PG8_LAS bf16x8*)(lds + PG8_SA(b, h) + aoff + m * 2048 + k * 1024); } while (0)
#define PG8_LDB(dst, b, h) do { _Pragma("unroll") for (int n = 0; n < 2; ++n) _Pragma("unroll") for (int k = 0; k < 2; ++k) dst[n][k] = *(const PG8_LAS bf16x8*)(lds + PG8_SB(b, h) + boff + n * 2048 + k * 1024); } while (0)
#define PG8_MMA(ai, bj, At, Bt) do { __builtin_amdgcn_s_setprio(1); _Pragma("unroll") for (int m = 0; m < 4; ++m) _Pragma("unroll") for (int n = 0; n < 2; ++n) _Pragma("unroll") for (int k = 0; k < 2; ++k) \
        acc[ai][bj][m][n] = __builtin_amdgcn_mfma_f32_16x16x32_bf16(Bt[n][k], At[m][k], acc[ai][bj][m][n], 0, 0, 0); __builtin_amdgcn_s_setprio(0); } while (0)
#define PG8_WAIT_V(n) asm volatile("s_waitcnt vmcnt(" #n ")" ::: "memory")
#define PG8_WAIT_L(n) asm volatile("s_waitcnt lgkmcnt(" #n ")" ::: "memory")
#define PG8_BAR __builtin_amdgcn_s_barrier()
#define PG8_SCHED __builtin_amdgcn_sched_barrier(0)
    Unit cur, nxt; int ui = 0;
    if (!S.next(0, cur)) return;
    f32x4 acc[2][2][4][2];
#pragma unroll
    for (int a = 0; a < 2; ++a)
#pragma unroll
        for (int b = 0; b < 2; ++b)
#pragma unroll
            for (int m = 0; m < 4; ++m)
#pragma unroll
                for (int n = 0; n < 2; ++n) acc[a][b][m][n] = (f32x4){0.f, 0.f, 0.f, 0.f};
    bf16x8 At[4][2], B0[2][2], B1[2][2];
    unsigned vA0[2], vA1[2], nA0[2], nA1[2];
    const char* cA; const char* cA1;
#define PG8_SET_A(u, o0, o1, p0, p1) do { \
        if constexpr (GATHER) { \
            _Pragma("unroll") for (int i = 0; i < 2; ++i) { const int r0 = rowtab[(u).aux + RA[i]], r1 = rowtab[(u).aux + HALF + RA[i]]; \
                o0[i] = (unsigned)(r0 * K + CA[i]) * 2u; o1[i] = (unsigned)(r1 * K + CA[i]) * 2u; } \
            p0 = (const char*)g.A; p1 = (const char*)g.A; \
        } else { \
            p0 = (const char*)g.A + (size_t)(u).pm * tstep; p1 = p0 + hstep; \
        } } while (0)
    PG8_SET_A(cur, vA0, vA1, cA, cA1);
    const char* cB = (const char*)g.Bt + (size_t)cur.pn * tstep;
    PG8_STAGE(PG8_SB(0, 0), cB, voffB); PG8_STAGE(PG8_SB(0, 1), cB + hstep, voffB); if constexpr (GATHER) { PG8_STAGE(PG8_SA(0, 0), cA, vA0); PG8_STAGE(PG8_SA(0, 1), cA1, vA1); } else { PG8_STAGE(PG8_SA(0, 0), cA, voffA); PG8_STAGE(PG8_SA(0, 1), cA1, voffA); }
    if (wr == 1) PG8_BAR;
    PG8_WAIT_V(2); PG8_BAR;
    PG8_STAGE(PG8_SB(1, 0), cB + kstep, voffB); if constexpr (GATHER) { PG8_STAGE(PG8_SA(1, 0), cA + kstep, vA0); } else { PG8_STAGE(PG8_SA(1, 0), cA + kstep, voffA); } PG8_STAGE(PG8_SB(1, 1), cB + hstep + kstep, voffB);
    PG8_WAIT_V(6); PG8_BAR;
    for (;;) {
        const bool has_next = S.next(ui + 1, nxt);
        const char* nA; const char* nA1b;
        if (has_next) PG8_SET_A(nxt, nA0, nA1, nA, nA1b);
        else {
            if constexpr (GATHER) {
#pragma unroll
                for (int i = 0; i < 2; ++i) { nA0[i] = vA0[i]; nA1[i] = vA1[i]; } }
            nA = cA; nA1b = cA1; }
        const char* nB = has_next ? (const char*)g.Bt + (size_t)nxt.pn * tstep : cB;
        for (int t = 0; t < nt; t += 2) {
            const bool last = (t == nt - 2);
            const char* a1h1 = cA1 + (size_t)(t + 1) * kstep;
            const char* a2h0 = last ? nA : cA + (size_t)(t + 2) * kstep; const char* a2h1 = last ? nA1b : cA1 + (size_t)(t + 2) * kstep;
            const char* b2 = last ? nB : cB + (size_t)(t + 2) * kstep;
            const char* a3h0 = a2h0 + kstep; const char* a3h1 = a2h1 + kstep; const char* b3 = b2 + kstep;
            unsigned w0[2], w1[2], x1[2];
#pragma unroll
            for (int i = 0; i < 2; ++i) { if constexpr (GATHER) { w0[i] = last ? nA0[i] : vA0[i]; w1[i] = last ? nA1[i] : vA1[i]; x1[i] = vA1[i]; } else { w0[i] = voffA[i]; w1[i] = voffA[i]; x1[i] = voffA[i]; } }
            PG8_LDB(B0, 0, 0); PG8_LDB(B1, 0, 1); PG8_SCHED; PG8_LDA(At, 0, 0); PG8_STAGE(PG8_SA(1, 1), a1h1, x1);
            PG8_WAIT_V(8); PG8_WAIT_L(0); PG8_BAR; PG8_MMA(0, 0, At, B0); PG8_MMA(0, 1, At, B1); PG8_BAR; PG8_SCHED;
            PG8_LDA(At, 0, 1); PG8_STAGE(PG8_SB(0, 0), b2, voffB); PG8_STAGE(PG8_SB(0, 1), b2 + hstep, voffB); PG8_STAGE(PG8_SA(0, 0), a2h0, w0);
            PG8_WAIT_V(8); PG8_WAIT_L(0); PG8_BAR; PG8_MMA(1, 0, At, B0); PG8_MMA(1, 1, At, B1); PG8_BAR; PG8_SCHED;
            PG8_LDB(B0, 1, 0); PG8_LDB(B1, 1, 1); PG8_SCHED; PG8_LDA(At, 1, 0); PG8_STAGE(PG8_SA(0, 1), a2h1, w1);
            PG8_WAIT_V(8); PG8_WAIT_L(0); PG8_BAR; PG8_MMA(0, 0, At, B0); PG8_MMA(0, 1, At, B1); PG8_BAR; PG8_SCHED;
            PG8_LDA(At, 1, 1); PG8_STAGE(PG8_SB(1, 0), b3, voffB); PG8_STAGE(PG8_SB(1, 1), b3 + hstep, voffB); PG8_STAGE(PG8_SA(1, 0), a3h0, w0);
            PG8_WAIT_V(8); PG8_WAIT_L(0); PG8_BAR; PG8_MMA(1, 0, At, B0); PG8_MMA(1, 1, At, B1); PG8_BAR; PG8_SCHED;
            (void)a3h1;
        }
        if constexpr (ALIGN_EPI) { if (wr == 0) PG8_BAR; }
        E(acc, cur, wr, wc, fr, fq);
        if (!has_next) break;
#pragma unroll
        for (int a = 0; a < 2; ++a)
#pragma unroll
            for (int b = 0; b < 2; ++b)
#pragma unroll
                for (int m = 0; m < 4; ++m)
#pragma unroll
                    for (int n = 0; n < 2; ++n) acc[a][b][m][n] = (f32x4){0.f, 0.f, 0.f, 0.f};
        cur = nxt; cA = nA; cA1 = nA1b; cB = nB; ++ui;
        if constexpr (GATHER) {
#pragma unroll
            for (int i = 0; i < 2; ++i) { vA0[i] = nA0[i]; vA1[i] = nA1[i]; } }
        if constexpr (ALIGN_EPI) { if (wr == 1) PG8_BAR; }
    }
    PG8_WAIT_V(0);
    if constexpr (!ALIGN_EPI) { if (wr == 0) PG8_BAR; }
    PG8_BAR;
#undef PG8_SET_A
#undef PG8_SA
#undef PG8_SB
#undef PG8_STAGE
#undef PG8_LDA
#undef PG8_LDB
#undef PG8_MMA
#undef PG8_WAIT_V
#undef PG8_WAIT_L
#undef PG8_BAR
#undef PG8_SCHED
}
}

constexpr int NWAVES = 8, NTHREADS = 512;
constexpr int BATCH = 2, T = 8192, D = 1024, M = BATCH * T;
constexpr int D_IN = 9304;
constexpr int MEM_LEN = 256, MM = BATCH * MEM_LEN;
constexpr float EPS = 1e-6f;
constexpr int N1 = 25 * 256;
constexpr int TOPK = 256;

constexpr size_t MiB = 1u << 20;
constexpr size_t WS_CTL = 0, CTL_ZERO_BYTES = 1 * MiB;
constexpr size_t WS_DEC = 1 * MiB;
constexpr size_t WS_SM = 2 * MiB;
constexpr size_t WS_MEMK = 6 * MiB;
constexpr size_t WS_MEMVT = 7 * MiB;
constexpr size_t WS_MEMN = 8 * MiB;
constexpr size_t WS_WR = 9 * MiB;
constexpr size_t WS_TOK = 10 * MiB;
constexpr size_t WS_XN = 16 * MiB;
constexpr size_t WS_GQK = 48 * MiB;
constexpr size_t WS_GV = 80 * MiB;
constexpr size_t WS_GG = 112 * MiB;
constexpr size_t WS_DQ = 144 * MiB;
constexpr size_t WS_MQ = 176 * MiB;
constexpr size_t WS_DKV = 208 * MiB;
constexpr size_t WS_IQ = 224 * MiB;
constexpr size_t WS_IDX = 240 * MiB;
constexpr size_t WS_END = 256 * MiB;
constexpr size_t WS_WGT = 240 * MiB;
constexpr size_t WS_WOT = 246 * MiB;
constexpr size_t WS_WOUTT = 252 * MiB;
constexpr size_t WS_MERGED = 208 * MiB;
constexpr size_t WS_GS = 80 * MiB;
constexpr size_t WS_MOEW = 48 * MiB;
constexpr size_t WS_H2 = 80 * MiB;
constexpr size_t WS_HID = 112 * MiB;
constexpr size_t TILE_BYTES = 256 * 1024 * 2;
constexpr size_t OUT_W1T = 0, OUT_WKVT = (size_t)N1 * D * 2;

constexpr int CW_TMO = 0, CW_CODE = 1;
constexpr int CW_BAR = 4096;

constexpr int RING_BYTES = 131072;
constexpr int LDSCTL_OFF = 160 * 1024 - 512, MISC_OFF = LDSCTL_OFF + 320;
constexpr int LDS_BYTES = 160 * 1024;

#define GAS __attribute__((address_space(1)))
#define LAS __attribute__((address_space(3)))
typedef unsigned short bf16;
typedef unsigned v4u __attribute__((ext_vector_type(4)));
typedef unsigned v2u __attribute__((ext_vector_type(2)));
typedef float f32x4 __attribute__((ext_vector_type(4)));
typedef float f32x16 __attribute__((ext_vector_type(16)));
typedef short bf16x8 __attribute__((ext_vector_type(8)));
typedef _Float16 f16x8 __attribute__((ext_vector_type(8)));
typedef GAS unsigned gu32;
#define RLX_AGENT __ATOMIC_RELAXED, __HIP_MEMORY_SCOPE_AGENT
#define LDS_WAIT() asm volatile("s_waitcnt lgkmcnt(0)" ::: "memory")
#define VM_WAIT() asm volatile("s_waitcnt vmcnt(0)" ::: "memory")
__device__ __forceinline__ unsigned f2bf(float f) { unsigned u = __builtin_bit_cast(unsigned, f); return (u + 0x7fffu + ((u >> 16) & 1u)) >> 16; }
__device__ __forceinline__ unsigned pk2(float lo, float hi) { return f2bf(lo) | (f2bf(hi) << 16); }
__device__ __forceinline__ float bf2f(unsigned short b) { return __builtin_bit_cast(float, (unsigned)b << 16); }

#define XB_TMO      128
#define XB_XCNT(j)  (256  + 64 * (j))
#define XB_XSUB(j)  (1280 + 64 * (j))
#define XB_XGEN(j)  (2304 + 64 * (j))
#define XB_TOP      3328
#define XB_TOPGEN   3392
#define XCD_BAR_WORDS 3456
#define XB_SPIN_CAP (1u << 18)
__device__ __forceinline__ unsigned xb_ld(unsigned* p)              { return __hip_atomic_load(p, __ATOMIC_RELAXED, __HIP_MEMORY_SCOPE_AGENT); }
__device__ __forceinline__ unsigned xb_add(unsigned* p, unsigned v) { return __hip_atomic_fetch_add(p, v, __ATOMIC_RELAXED, __HIP_MEMORY_SCOPE_AGENT); }
__device__ __forceinline__ unsigned xb_xcc_id() { return (unsigned)__builtin_amdgcn_s_getreg((3 << 11) | 20) & 0xFu; }
#define XB_SPIN(cond, bar) do { unsigned _sp = 0; while (cond) { __builtin_amdgcn_s_sleep(1); \
    if ((++_sp & 255u) == 0u) { if (xb_ld(&(bar)[XB_TMO])) break; if (_sp > XB_SPIN_CAP) { atomicAdd(&(bar)[XB_TMO], 1u); break; } } } } while (0)
struct XcdBarrier { unsigned* bar; unsigned x; volatile LAS unsigned* st; };
__device__ __forceinline__ XcdBarrier xcd_barrier_post(unsigned* bar, volatile LAS unsigned* st) {
    XcdBarrier b; b.bar = bar; b.x = xb_xcc_id(); b.st = st;
    if (threadIdx.x == 0) (void)xb_add(&bar[XB_XCNT(b.x)], 1u);
    return b;
}
__device__ __forceinline__ void xcd_barrier_complete(unsigned* bar, unsigned x, unsigned& nloc, unsigned& nx) {
    const unsigned G = gridDim.x * gridDim.y * gridDim.z;
    unsigned sum, cnt, mine, sp = 0u;
    for (;;) {
        sum = 0u; cnt = 0u; mine = 0u;
#pragma unroll
        for (unsigned j = 0; j < 16; ++j) { const unsigned c = xb_ld(&bar[XB_XCNT(j)]); sum += c; cnt += (c > 0u) ? 1u : 0u; mine = (j == x) ? c : mine; }
        if (sum == G) break;
        __builtin_amdgcn_s_sleep(1);
        if ((++sp & 255u) == 0u) { if (xb_ld(&bar[XB_TMO])) break; if (sp > XB_SPIN_CAP) { atomicAdd(&bar[XB_TMO], 1u); break; } }
    }
    nloc = mine > 0u ? mine : 1u; nx = cnt > 0u ? cnt : 1u;
}
__device__ __forceinline__ void xcd_barrier(const XcdBarrier& b) {
    asm volatile("s_waitcnt vmcnt(0)" ::: "memory");
    __syncthreads();
    if (threadIdx.x == 0) {
        unsigned* bar = b.bar;
        __builtin_amdgcn_s_waitcnt(0);
        unsigned nloc = b.st[0], nx = b.st[1];
        if (nloc == 0u) { xcd_barrier_complete(bar, b.x, nloc, nx); b.st[0] = nloc; b.st[1] = nx; }
        const unsigned old = xb_add(&bar[XB_XSUB(b.x)], 1u);
        const unsigned gen = old / nloc;
        if (old + 1u == (gen + 1u) * nloc) {
            __builtin_amdgcn_fence(__ATOMIC_RELEASE, "agent");
            asm volatile("s_waitcnt vmcnt(0)" ::: "memory");
            const unsigned og = xb_add(&bar[XB_TOP], 1u);
            const unsigned tg = og / nx;
            if (og + 1u == (tg + 1u) * nx) xb_add(&bar[XB_TOPGEN], 1u);
            else XB_SPIN(xb_ld(&bar[XB_TOPGEN]) == tg, bar);
            __builtin_amdgcn_fence(__ATOMIC_ACQUIRE, "agent");
            xb_add(&bar[XB_XGEN(b.x)], 1u);
            asm volatile("s_waitcnt vmcnt(0)" ::: "memory");
        } else {
            XB_SPIN(xb_ld(&bar[XB_XGEN(b.x)]) == gen, bar);
            __builtin_amdgcn_fence(__ATOMIC_ACQUIRE, "agent");
            asm volatile("s_waitcnt vmcnt(0)" ::: "memory");
        }
    }
    __syncthreads();
}

struct Args { const float* in[27]; float* out; unsigned char* ws; int ph_lo, ph_hi; };
struct Frame {
    LAS unsigned char* lds;
    volatile LAS unsigned* MISC;
    gu32* ctl;
    int tid, lane, wave;
    int vcu, G;
    unsigned char* ws; unsigned char* outb;
};
__device__ __forceinline__ float wave_sum(float v) {
#pragma unroll
    for (int o = 1; o < 64; o <<= 1) v += __shfl_xor(v, o);
    return v;
}

__device__ __forceinline__ void tr_item(const float* W, int ldw, int srccol, bf16* WT, int K, int n0, int k0, LAS float* scr, int lane, int k0src = -1) {
    if (k0src < 0) k0src = k0;
#pragma unroll 8
    for (int i = 0; i < 32; ++i) { const int kk = 2 * i + (lane >> 5); scr[kk * 33 + (lane & 31)] = srccol >= 0 ? W[(size_t)(k0src + kk) * ldw + srccol] : 0.f; }
    LDS_WAIT(); asm volatile("" ::: "memory");
    const int c = lane & 7;
#pragma unroll
    for (int j = 0; j < 4; ++j) { const int n = (lane >> 3) + 8 * j; const LAS float* s = scr + (8 * c) * 33 + n;
        v4u o; o.x = pk2(s[0 * 33], s[1 * 33]); o.y = pk2(s[2 * 33], s[3 * 33]); o.z = pk2(s[4 * 33], s[5 * 33]); o.w = pk2(s[6 * 33], s[7 * 33]);
        *(GAS v4u*)(WT + (size_t)(n0 + n) * K + k0 + 8 * c) = o; }
    LDS_WAIT(); asm volatile("" ::: "memory");
}
__device__ __forceinline__ int w1_src(int n) {
    if (n < 3072) return n;
    if (n < 4096) return 3088 + (n - 3072);
    if (n < 4608) return 4112 + (n - 4096);
    if (n < 5120) return 4624 + (n - 4608);
    if (n < 6144) return 5208 + (n - 5120);
    const int j = n - 6144;
    if (j < 16) return 3072 + j;
    if (j < 88) return 5136 + (j - 16);
    return -1;
}
__device__ __forceinline__ void rms_row_to_bf16(const float* xrow, const float* gain, bf16* orow, int lane) {
    const GAS f32x4* xr = (const GAS f32x4*)xrow + lane; const GAS f32x4* gr = (const GAS f32x4*)gain + lane;
    f32x4 v[4]; float s = 0.f;
#pragma unroll
    for (int j = 0; j < 4; ++j) { v[j] = xr[64 * j]; s += (v[j].x * v[j].x + v[j].y * v[j].y) + (v[j].z * v[j].z + v[j].w * v[j].w); }
    const float r = 1.f / sqrtf(wave_sum(s) * (1.f / D) + EPS);
    GAS unsigned long long* o8 = (GAS unsigned long long*)orow + lane;
#pragma unroll
    for (int j = 0; j < 4; ++j) { const f32x4 gg = gr[64 * j];
        o8[64 * j] = (unsigned long long)pk2(v[j].x * r * gg.x, v[j].y * r * gg.y) | ((unsigned long long)pk2(v[j].z * r * gg.z, v[j].w * r * gg.w) << 32); }
}
__device__ __forceinline__ void p0_prologue(Frame& F, const Args& a) {
    LAS float* scr = (LAS float*)(F.lds + F.wave * 16384);
    const int gw = F.vcu * NWAVES + F.wave, NGW = F.G * NWAVES;
    bf16* W1t = (bf16*)(F.outb + OUT_W1T); bf16* Wkvt = (bf16*)(F.outb + OUT_WKVT);
    constexpr int I_1 = (D / 64) * (N1 / 32), I_KV = (D / 64) * (2048 / 32);
    for (int it = gw; it < I_1 + I_KV; it += NGW) {
        if (it < I_1) { const int kb = it / (N1 / 32), nb = it % (N1 / 32); tr_item(a.in[4], D_IN, w1_src(nb * 32 + (F.lane & 31)), W1t, D, nb * 32, kb * 64, scr, F.lane); }
        else { const int r = it - I_1, kb = r / 64, nb = r % 64; tr_item(a.in[8], 2048, nb * 32 + (F.lane & 31), Wkvt, D, nb * 32, kb * 64, scr, F.lane); }
    }
    bf16* XN = (bf16*)(F.ws + WS_XN); bf16* MEMN = (bf16*)(F.ws + WS_MEMN);
    for (int m = gw; m < M + MM; m += NGW) {
        if (m < M) rms_row_to_bf16(a.in[0] + (size_t)m * D, a.in[2], XN + (size_t)m * D, F.lane);
        else rms_row_to_bf16(a.in[1] + (size_t)(m - M) * D, a.in[3], MEMN + (size_t)(m - M) * D, F.lane);
    }
}

struct EpiG1 {
    static constexpr bool PERM = true;
    unsigned char* ws;
    __device__ __forceinline__ void operator()(const pg8::f32x4 (&acc)[2][2][4][2], const pg8::Unit& u, int wr, int wc, int fr, int fq) const {
        const int pn = u.pn; size_t off; int ld, c0; bool f16 = false, half_only = false;
        if (pn < 4) { off = WS_GQK; ld = 1024; c0 = pn * 256; }
        else if (pn < 8) { off = WS_GV; ld = 1024; c0 = (pn - 4) * 256; }
        else if (pn < 12) { off = WS_GG; ld = 1024; c0 = (pn - 8) * 256; }
        else if (pn < 16) { off = WS_DQ; ld = 1024; c0 = (pn - 12) * 256; }
        else if (pn < 18) { off = WS_DKV; ld = 512; c0 = (pn - 16) * 256; }
        else if (pn < 20) { off = WS_IQ; ld = 512; c0 = (pn - 18) * 256; f16 = true; }
        else if (pn < 24) { off = WS_MQ; ld = 1024; c0 = (pn - 20) * 256; }
        else { off = WS_SM; ld = 128; c0 = 0; f16 = true; half_only = true; }
        unsigned short* base = (unsigned short*)(ws + off);
        const int row0 = u.pm * 256 + wr * 64 + fr, col0 = c0 + wc * 32 + 8 * fq;
#pragma unroll
        for (int ai = 0; ai < 2; ++ai)
#pragma unroll
            for (int m = 0; m < 4; ++m) { unsigned short* rowp = base + (size_t)(row0 + ai * 128 + m * 16) * ld + col0;
#pragma unroll
                for (int bj = 0; bj < 2; ++bj) { if (bj == 1 && half_only) continue;
                    const pg8::f32x4 v0 = acc[ai][bj][m][0], v1 = acc[ai][bj][m][1]; pg8::u32x4 w;
                    if (f16) { w.x = pg8::cvt_pk_f16(v0[0], v0[1]); w.y = pg8::cvt_pk_f16(v0[2], v0[3]); w.z = pg8::cvt_pk_f16(v1[0], v1[1]); w.w = pg8::cvt_pk_f16(v1[2], v1[3]); }
                    else { w.x = pg8::cvt_pk_bf16(v0[0], v0[1]); w.y = pg8::cvt_pk_bf16(v0[2], v0[3]); w.z = pg8::cvt_pk_bf16(v1[0], v1[1]); w.w = pg8::cvt_pk_bf16(v1[2], v1[3]); }
                    *(pg8::u32x4*)(rowp + bj * 128) = w; } }
    }
};
struct EpiPlain {
    static constexpr bool PERM = true;
    unsigned short* O; int ld;
    __device__ __forceinline__ void operator()(const pg8::f32x4 (&acc)[2][2][4][2], const pg8::Unit& u, int wr, int wc, int fr, int fq) const {
        const int row0 = u.pm * 256 + wr * 64 + fr, col0 = u.aux * 256 + wc * 32 + 8 * fq;
#pragma unroll
        for (int ai = 0; ai < 2; ++ai)
#pragma unroll
            for (int m = 0; m < 4; ++m) { unsigned short* rowp = O + (size_t)(row0 + ai * 128 + m * 16) * ld + col0;
#pragma unroll
                for (int bj = 0; bj < 2; ++bj) { const pg8::f32x4 v0 = acc[ai][bj][m][0], v1 = acc[ai][bj][m][1]; pg8::u32x4 w;
                    w.x = pg8::cvt_pk_bf16(v0[0], v0[1]); w.y = pg8::cvt_pk_bf16(v0[2], v0[3]); w.z = pg8::cvt_pk_bf16(v1[0], v1[1]); w.w = pg8::cvt_pk_bf16(v1[2], v1[3]);
                    *(pg8::u32x4*)(rowp + bj * 128) = w; } }
    }
};
struct OneUnit {
    int idx, nN, pn0;
    __device__ bool next(int i, pg8::Unit& u) const { if (i != 0 || idx < 0) return false; u.pm = idx / nN; u.pn = pn0 + idx % nN; u.aux = idx % nN; return true; }
};

constexpr int GLA_AL = 0, GLA_TOT = 4096, GLA_QD = 8192, GLA_KI = GLA_QD + 64 * 272, GLA_VT = GLA_KI + 64 * 272, GLA_ATT = GLA_VT + 256 * 144, GLA_RS = GLA_ATT + 64 * 144, GLA_RSTD = GLA_RS + 2048;
constexpr int GLA_KE = GLA_QD;
static_assert(128 * 144 <= 2 * 64 * 272, "KE fits");
__device__ __forceinline__ float log_sigmoid(float z) { return fminf(z, 0.f) - __logf(1.f + __expf(-fabsf(z))); }

__device__ __forceinline__ void gla_cum(Frame& F, const Args& a, int b, int n, int h, float (&c)[16], float& last) {
    const int r0 = b * T + n * 64, d = F.tid & 127, jq = F.tid >> 7;
    const _Float16* SM = (const _Float16*)(F.ws + WS_SM);
    LAS float* AL = (LAS float*)(F.lds + GLA_AL); LAS float* TOT = (LAS float*)(F.lds + GLA_TOT);
#pragma unroll
    for (int i = 0; i < 2; ++i) { const int idx = F.tid + 512 * i, j = idx >> 4, r = idx & 15; AL[idx] = (float)SM[(size_t)(r0 + j) * 128 + r]; }
    float w2[16];
#pragma unroll
    for (int r = 0; r < 16; ++r) w2[r] = a.in[5][r * 512 + h * 128 + d];
    const float b2 = a.in[6][h * 128 + d];
    __syncthreads();
    float cum = 0.f;
#pragma unroll
    for (int jj = 0; jj < 16; ++jj) { const int j = 16 * jq + jj; float z = b2;
#pragma unroll
        for (int r = 0; r < 16; ++r) z += AL[j * 16 + r] * w2[r];
        cum += log_sigmoid(z) * (1.f / 16.f); c[jj] = cum; }
    TOT[jq * 128 + d] = cum;
    __syncthreads();
    float off = 0.f; last = 0.f;
#pragma unroll
    for (int q = 0; q < 4; ++q) { const float t = TOT[q * 128 + d]; last += t; if (q < jq) off += t; }
#pragma unroll
    for (int jj = 0; jj < 16; ++jj) c[jj] += off;
}
__device__ __forceinline__ void gla_stage_vt(Frame& F, int b, int n, int h) {
    const int r0 = b * T + n * 64; const bf16* GV = (const bf16*)(F.ws + WS_GV);
#pragma unroll
    for (int it = 0; it < 4; ++it) { const int idx = F.tid + 512 * it, j = idx >> 5, ch = idx & 31;
        const v4u v = *(const GAS v4u*)(GV + (size_t)(r0 + j) * 1024 + h * 256 + ch * 8);
        LAS unsigned short* dst = (LAS unsigned short*)(F.lds + GLA_VT + (ch * 8) * 144 + j * 2);
        dst[0 * 72] = (unsigned short)(v.x & 0xffff); dst[1 * 72] = (unsigned short)(v.x >> 16); dst[2 * 72] = (unsigned short)(v.y & 0xffff); dst[3 * 72] = (unsigned short)(v.y >> 16);
        dst[4 * 72] = (unsigned short)(v.z & 0xffff); dst[5 * 72] = (unsigned short)(v.z >> 16); dst[6 * 72] = (unsigned short)(v.w & 0xffff); dst[7 * 72] = (unsigned short)(v.w >> 16); }
}
__device__ __forceinline__ void gla_b1_item(Frame& F, const Args& a, int item) {
    const int h = item & 3, n = (item >> 2) & 127, b = item >> 9, r0 = b * T + n * 64, d = F.tid & 127, jq = F.tid >> 7;
    float c[16], last; gla_cum(F, a, b, n, h, c, last);
    const bf16* GQK = (const bf16*)(F.ws + WS_GQK);
    unsigned pk[8];
#pragma unroll
    for (int jj = 0; jj < 16; jj += 2) { const int j = 16 * jq + jj;
        const float k0 = bf2f(GQK[(size_t)(r0 + j) * 1024 + 512 + h * 128 + d]), k1 = bf2f(GQK[(size_t)(r0 + j + 1) * 1024 + 512 + h * 128 + d]);
        pk[jj >> 1] = pk2(k0 * __expf(last - c[jj]), k1 * __expf(last - c[jj + 1])); }
    LAS v4u* ke = (LAS v4u*)(F.lds + GLA_KE + d * 144 + jq * 32);
    ke[0] = (v4u){pk[0], pk[1], pk[2], pk[3]}; ke[1] = (v4u){pk[4], pk[5], pk[6], pk[7]};
    if (jq == 0) ((float*)(F.ws + WS_DEC))[(size_t)item * 128 + d] = __expf(last);
    gla_stage_vt(F, b, n, h);
    __syncthreads();
    const int r = F.lane & 31, hh = F.lane >> 5, w = F.wave;
    f32x16 acc[4];
#pragma unroll
    for (int t = 0; t < 4; ++t) acc[t] = (f32x16){};
#pragma unroll
    for (int s = 0; s < 4; ++s) {
        const bf16x8 af = *(const LAS bf16x8*)(F.lds + GLA_VT + (32 * w + r) * 144 + 32 * s + 16 * hh);
#pragma unroll
        for (int t = 0; t < 4; ++t) { const bf16x8 bf = *(const LAS bf16x8*)(F.lds + GLA_KE + (32 * t + r) * 144 + 32 * s + 16 * hh);
            acc[t] = __builtin_amdgcn_mfma_f32_32x32x16_bf16(af, bf, acc[t], 0, 0, 0); } }
    bf16* ST = (bf16*)F.outb + (size_t)item * 32768;
#pragma unroll
    for (int t = 0; t < 4; ++t)
#pragma unroll
        for (int i = 0; i < 16; ++i) { const int row = (i & 3) + 8 * (i >> 2) + 4 * hh; ST[(32 * w + row) * 128 + 32 * t + r] = (bf16)f2bf(acc[t][i]); }
    __syncthreads();
}
__device__ __forceinline__ void gla_b2_scan(Frame& F) {
    unsigned* ST = (unsigned*)F.outb; const float* DEC = (const float*)(F.ws + WS_DEC);
    for (int e = (int)blockIdx.x * NTHREADS + F.tid; e < 131072; e += F.G * NTHREADS) {
        const int dkp = e & 63, dv = (e >> 6) & 255, h = (e >> 14) & 3, b = e >> 16;
        float s0 = 0.f, s1 = 0.f;
        for (int n0 = 0; n0 < 128; n0 += 8) {
            unsigned u[8]; float d0[8], d1[8];
#pragma unroll
            for (int k = 0; k < 8; ++k) { const size_t it = (size_t)((b * 128 + n0 + k) * 4 + h); u[k] = ST[it * 16384 + dv * 64 + dkp]; const float* dp = DEC + it * 128 + 2 * dkp; d0[k] = dp[0]; d1[k] = dp[1]; }
#pragma unroll
            for (int k = 0; k < 8; ++k) { const size_t it = (size_t)((b * 128 + n0 + k) * 4 + h); ST[it * 16384 + dv * 64 + dkp] = pk2(s0, s1);
                s0 = d0[k] * s0 + bf2f((unsigned short)(u[k] & 0xffff)); s1 = d1[k] * s1 + bf2f((unsigned short)(u[k] >> 16)); }
        }
    }
}
__device__ __forceinline__ void gla_b3_item(Frame& F, const Args& a, int item) {
    const int h = item & 3, n = (item >> 2) & 127, b = item >> 9, r0 = b * T + n * 64, d = F.tid & 127, jq = F.tid >> 7;
    float c[16], last; gla_cum(F, a, b, n, h, c, last);
    const bf16* GQK = (const bf16*)(F.ws + WS_GQK);
    const float qscale = 0.08838834764831845f;
#pragma unroll
    for (int jj = 0; jj < 16; ++jj) { const int j = 16 * jq + jj;
        const float q = bf2f(GQK[(size_t)(r0 + j) * 1024 + h * 128 + d]), k = bf2f(GQK[(size_t)(r0 + j) * 1024 + 512 + h * 128 + d]);
        *(LAS unsigned short*)(F.lds + GLA_QD + j * 272 + d * 2) = (unsigned short)f2bf(q * qscale * __expf(c[jj]));
        *(LAS unsigned short*)(F.lds + GLA_KI + j * 272 + d * 2) = (unsigned short)f2bf(k * __expf(-c[jj])); }
    gla_stage_vt(F, b, n, h);
    __syncthreads();
    const int r = F.lane & 31, hh = F.lane >> 5, w = F.wave;
    if (w < 4) {
        const int mi = w >> 1, nj = w & 1; f32x16 at = (f32x16){};
#pragma unroll
        for (int s = 0; s < 8; ++s) { const bf16x8 af = *(const LAS bf16x8*)(F.lds + GLA_QD + (32 * mi + r) * 272 + 32 * s + 16 * hh);
            const bf16x8 bf = *(const LAS bf16x8*)(F.lds + GLA_KI + (32 * nj + r) * 272 + 32 * s + 16 * hh);
            at = __builtin_amdgcn_mfma_f32_32x32x16_bf16(af, bf, at, 0, 0, 0); }
#pragma unroll
        for (int i = 0; i < 16; ++i) { const int row = 32 * mi + (i & 3) + 8 * (i >> 2) + 4 * hh, col = 32 * nj + r;
            *(LAS unsigned short*)(F.lds + GLA_ATT + row * 144 + col * 2) = (unsigned short)f2bf(row >= col ? at[i] : 0.f); }
    }
    const bf16* ST = (const bf16*)F.outb + (size_t)item * 32768;
    bf16x8 sf[8];
#pragma unroll
    for (int s = 0; s < 8; ++s) sf[s] = *(const GAS bf16x8*)(ST + (32 * w + r) * 128 + 16 * s + 8 * hh);
    __syncthreads();
    f32x16 acc[2]; acc[0] = (f32x16){}; acc[1] = (f32x16){};
#pragma unroll
    for (int s = 0; s < 4; ++s) { const bf16x8 bf = *(const LAS bf16x8*)(F.lds + GLA_VT + (32 * w + r) * 144 + 32 * s + 16 * hh);
#pragma unroll
        for (int mi = 0; mi < 2; ++mi) { const bf16x8 af = *(const LAS bf16x8*)(F.lds + GLA_ATT + (32 * mi + r) * 144 + 32 * s + 16 * hh);
            acc[mi] = __builtin_amdgcn_mfma_f32_32x32x16_bf16(af, bf, acc[mi], 0, 0, 0); } }
#pragma unroll
    for (int s = 0; s < 8; ++s)
#pragma unroll
        for (int mi = 0; mi < 2; ++mi) { const bf16x8 af = *(const LAS bf16x8*)(F.lds + GLA_QD + (32 * mi + r) * 272 + 32 * s + 16 * hh);
            acc[mi] = __builtin_amdgcn_mfma_f32_32x32x16_bf16(af, sf[s], acc[mi], 0, 0, 0); }
    LAS float* RS = (LAS float*)(F.lds + GLA_RS); LAS float* RSTD = (LAS float*)(F.lds + GLA_RSTD);
#pragma unroll
    for (int mi = 0; mi < 2; ++mi)
#pragma unroll
        for (int i = 0; i < 16; ++i) { float q = acc[mi][i] * acc[mi][i];
            q += __shfl_xor(q, 1); q += __shfl_xor(q, 2); q += __shfl_xor(q, 4); q += __shfl_xor(q, 8); q += __shfl_xor(q, 16);
            if (r == 0) RS[w * 64 + 32 * mi + (i & 3) + 8 * (i >> 2) + 4 * hh] = q; }
    __syncthreads();
    if (F.tid < 64) { float t = 0.f;
#pragma unroll
        for (int ww = 0; ww < 8; ++ww) t += RS[ww * 64 + F.tid];
        RSTD[F.tid] = 1.f / sqrtf(t * (1.f / 256.f) + EPS); }
    __syncthreads();
    bf16* GG = (bf16*)(F.ws + WS_GG); const float ng = a.in[7][32 * w + r];
#pragma unroll
    for (int mi = 0; mi < 2; ++mi)
#pragma unroll
        for (int i = 0; i < 16; ++i) { const int row = 32 * mi + (i & 3) + 8 * (i >> 2) + 4 * hh; bf16* p = GG + (size_t)(r0 + row) * 1024 + h * 256 + 32 * w + r;
            const float gt = bf2f(*p), sil = gt / (1.f + __expf(-gt)); *p = (bf16)f2bf(acc[mi][i] * RSTD[row] * ng * sil); }
    __syncthreads();
}

__device__ __forceinline__ void conv_mid_weights(Frame& F, const Args& a) {
    LAS float* scr = (LAS float*)(F.lds + F.wave * 16384);
    const int gw = F.vcu * NWAVES + F.wave, NGW = F.G * NWAVES;
    constexpr int I_G = 16 * (3072 / 32), I_O = 16 * (1024 / 32);
    for (int it = gw; it < I_G + 4 * I_O; it += NGW) {
        if (it < I_G) { const int kb = it / 96, nb = it % 96; tr_item(a.in[4], D_IN, 6232 + nb * 32 + (F.lane & 31), (bf16*)(F.ws + WS_WGT), D, nb * 32, kb * 64, scr, F.lane); }
        else { const int r = it - I_G, mtx = r / I_O, q = r % I_O, kb = q / 32, nb = q % 32;
            const float* W = a.in[15 + mtx];
            bf16* WT = (bf16*)(F.ws + (mtx < 3 ? WS_WOT + (size_t)mtx * 2 * MiB : WS_WOUTT));
            tr_item(W, 1024, nb * 32 + (F.lane & 31), WT, D, nb * 32, kb * 64, scr, F.lane); }
    }
}

#ifndef BRANCH_MASK
#define BRANCH_MASK 7
#endif
struct MergeSched {
    int G, c;
    __device__ bool next(int i, pg8::Unit& u) const {
        const int tile = c + (i / 6) * G; if (tile >= 256) return false;
        const int sub = i % 6, j = sub >> 1, pm = tile >> 2, pn = tile & 3;
        if (sub & 1) { u.pm = (int)((j == 0 ? WS_GG : j == 1 ? WS_DQ : WS_MQ) / TILE_BYTES) + pm; u.pn = (int)(WS_WOT / TILE_BYTES) + j * 4 + pn; }
        else { u.pm = (int)(WS_XN / TILE_BYTES) + pm; u.pn = (int)(WS_WGT / TILE_BYTES) + j * 4 + pn; }
        u.aux = sub | (pm << 8) | (pn << 16); return true;
    }
};
struct EpiMerge {
    static constexpr bool PERM = true;
    unsigned char* ws; float* part; const float* bgate; int wg;
    __device__ __forceinline__ void operator()(const pg8::f32x4 (&acc)[2][2][4][2], const pg8::Unit& u, int wr, int wc, int fr, int fq) const {
        const int sub = u.aux & 255, pm = (u.aux >> 8) & 255, pn = u.aux >> 16, j = sub >> 1;
        unsigned short* GS = (unsigned short*)(ws + WS_GS) + (size_t)wg * 65536;
        int fr_ = fr, fq_ = fq; asm volatile("" : "+v"(fr_), "+v"(fq_));
        const int lrow0 = wr * 64 + fr_, lcol0 = wc * 32 + 8 * fq_;
        if (!(sub & 1)) {
#pragma unroll
            for (int bj = 0; bj < 2; ++bj) { f32x4 bv[2];
#pragma unroll
              for (int n = 0; n < 2; ++n) bv[n] = *(const f32x4*)(bgate + j * 1024 + pn * 256 + bj * 128 + lcol0 + 4 * n);
#pragma unroll
              for (int ai = 0; ai < 2; ++ai)
#pragma unroll
                for (int m = 0; m < 4; ++m) { float g[8];
#pragma unroll
                        for (int n = 0; n < 2; ++n)
#pragma unroll
                            for (int e = 0; e < 4; ++e) g[4 * n + e] = 1.f / (1.f + __expf(-(acc[ai][bj][m][n][e] + bv[n][e])));
                        pg8::u32x4 w; w.x = pg8::cvt_pk_bf16(g[0], g[1]); w.y = pg8::cvt_pk_bf16(g[2], g[3]); w.z = pg8::cvt_pk_bf16(g[4], g[5]); w.w = pg8::cvt_pk_bf16(g[6], g[7]);
                        *(pg8::u32x4*)(GS + (lrow0 + ai * 128 + m * 16) * 256 + bj * 128 + lcol0) = w; }
              asm volatile("" ::: "memory"); }
        } else {
            const bool en = (BRANCH_MASK >> j) & 1;
            unsigned short* MG = (unsigned short*)(ws + WS_MERGED);
#pragma unroll
            for (int ai = 0; ai < 2; ++ai)
#pragma unroll
                for (int m = 0; m < 4; ++m)
#pragma unroll
                    for (int bj = 0; bj < 2; ++bj) {
                        const pg8::u32x4 gw = *(const pg8::u32x4*)(GS + (lrow0 + ai * 128 + m * 16) * 256 + bj * 128 + lcol0);
                        const size_t go = (size_t)(pm * 256 + lrow0 + ai * 128 + m * 16) * 1024 + pn * 256 + bj * 128 + lcol0;
                        float v[8];
#pragma unroll
                        for (int n = 0; n < 2; ++n)
#pragma unroll
                            for (int e = 0; e < 4; ++e) { const unsigned wd = gw[(4 * n + e) >> 1]; const float g = __builtin_bit_cast(float, (e & 1) ? (wd & 0xffff0000u) : (wd << 16));
                                v[4 * n + e] = en ? g * acc[ai][bj][m][n][e] : 0.f; }
                        if (j > 0) { const f32x4 p0 = *(const f32x4*)(part + go), p1 = *(const f32x4*)(part + go + 4);
#pragma unroll
                            for (int e = 0; e < 4; ++e) { v[e] += p0[e]; v[4 + e] += p1[e]; } }
                        if (j < 2) { *(f32x4*)(part + go) = (f32x4){v[0], v[1], v[2], v[3]}; *(f32x4*)(part + go + 4) = (f32x4){v[4], v[5], v[6], v[7]}; }
                        else { pg8::u32x4 w; w.x = pg8::cvt_pk_bf16(v[0], v[1]); w.y = pg8::cvt_pk_bf16(v[2], v[3]); w.z = pg8::cvt_pk_bf16(v[4], v[5]); w.w = pg8::cvt_pk_bf16(v[6], v[7]);
                            *(pg8::u32x4*)(MG + go) = w; }
                        asm volatile("" ::: "memory");
                    }
        }
    }
};
struct EpiResid {
    static constexpr bool PERM = false;
    const float* x; float* out;
    __device__ __forceinline__ void operator()(const pg8::f32x4 (&acc)[2][2][4][2], const pg8::Unit& u, int wr, int wc, int fr, int fq) const {
        const int pm = u.aux >> 8, pn = u.aux & 255;
        const int row0 = pm * 256 + wr * 64 + fr, col0 = pn * 256 + wc * 32 + 4 * fq;
#pragma unroll
        for (int ai = 0; ai < 2; ++ai)
#pragma unroll
            for (int m = 0; m < 4; ++m) { const size_t ro = (size_t)(row0 + ai * 128 + m * 16) * 1024 + col0;
#pragma unroll
                for (int bj = 0; bj < 2; ++bj)
#pragma unroll
                    for (int n = 0; n < 2; ++n) { const f32x4 xv = *(const f32x4*)(x + ro + bj * 128 + n * 16); *(f32x4*)(out + ro + bj * 128 + n * 16) = xv + acc[ai][bj][m][n]; } }
    }
};
struct OutSched {
    int G, c;
    __device__ bool next(int i, pg8::Unit& u) const { const int tile = c + i * G; if (tile >= 256) return false; const int pm = tile >> 2, pn = tile & 3;
        u.pm = (int)(WS_MERGED / TILE_BYTES) + pm; u.pn = (int)(WS_WOUTT / TILE_BYTES) + pn; u.aux = (pm << 8) | pn; return true; }
};

constexpr int CW_CNT = 8192;
constexpr size_t CTL_ROWTAB = 512 * 1024;
constexpr size_t WS_CW = WS_TOK;
__device__ __forceinline__ void conv_moe_weights(Frame& F, const Args& a) {
    LAS float* scr = (LAS float*)(F.lds + F.wave * 16384);
    const int gw = F.vcu * NWAVES + F.wave, NGW = F.G * NWAVES;
    bf16* Wgu = (bf16*)(F.ws + WS_MOEW); bf16* Wd = (bf16*)(F.ws + WS_MOEW + 16 * MiB);
    for (int it = gw; it < 4096 + 2048; it += NGW) {
        if (it < 4096) { const int kb = it & 15, nb = (it >> 4) & 7, pnl = (it >> 7) & 7, g = it >> 10, e = 4 * g + (pnl >> 1), hf = pnl & 1;
            const float* W = (nb < 4 ? a.in[24] : a.in[25]) + (size_t)e * 1024 * 256;
            tr_item(W, 256, hf * 128 + (nb & 3) * 32 + (F.lane & 31), Wgu, D, (g * 8 + pnl) * 256 + nb * 32, kb * 64, scr, F.lane); }
        else { const int r = it - 4096, fb = r & 3, nb = (r >> 2) & 31, el = (r >> 7) & 3, g = r >> 9;
            const float* W = a.in[26] + (size_t)(4 * g + el) * 256 * 1024;
            tr_item(W, 1024, nb * 32 + (F.lane & 31), Wd, D, g * 1024 + nb * 32, el * 256 + fb * 64, scr, F.lane, fb * 64); }
    }
}
__device__ __forceinline__ void build_router_weights(Frame& F, const Args& a) {
    float* WR = (float*)(F.ws + WS_WR);
    for (int i = (int)blockIdx.x * NTHREADS + F.tid; i < 20 * 1024; i += F.G * NTHREADS) { const int c = i >> 10, k = i & 1023;
        WR[i] = c < 4 ? a.in[20][k * 4 + c] : a.in[22][k * 16 + (c - 4)]; }
}
__device__ __forceinline__ void router_phase(Frame& F, const Args& a) {
    const int gw = F.vcu * NWAVES + F.wave, NGW = F.G * NWAVES;
    const float* WR = (const float*)(F.ws + WS_WR); bf16* H2 = (bf16*)(F.ws + WS_H2);
    int* rowtab = (int*)(F.ws + WS_CTL + CTL_ROWTAB); float* CWt = (float*)(F.ws + WS_CW);
    for (int m = gw; m < M; m += NGW) {
        const GAS f32x4* xr = (const GAS f32x4*)(a.out + (size_t)m * D) + F.lane; const GAS f32x4* gr = (const GAS f32x4*)a.in[19] + F.lane;
        f32x4 v[4]; float s = 0.f;
#pragma unroll
        for (int j = 0; j < 4; ++j) { v[j] = xr[64 * j]; s += (v[j].x * v[j].x + v[j].y * v[j].y) + (v[j].z * v[j].z + v[j].w * v[j].w); }
        const float r = 1.f / sqrtf(wave_sum(s) * (1.f / D) + EPS);
        GAS unsigned long long* o8 = (GAS unsigned long long*)(H2 + (size_t)m * D) + F.lane;
#pragma unroll
        for (int j = 0; j < 4; ++j) { const f32x4 gg = gr[64 * j]; v[j] = (f32x4){v[j].x * r * gg.x, v[j].y * r * gg.y, v[j].z * r * gg.z, v[j].w * r * gg.w};
            o8[64 * j] = (unsigned long long)pk2(v[j].x, v[j].y) | ((unsigned long long)pk2(v[j].z, v[j].w) << 32); }
        float lg[20]; const unsigned lo4 = (unsigned)F.lane * 4u;
#pragma unroll
        for (int c = 0; c < 20; ++c) { float p = 0.f;
#pragma unroll
            for (int j = 0; j < 4; ++j) { const f32x4 wv = *(const GAS f32x4*)((const GAS float*)WR + c * 1024 + (lo4 + 256u * j)); p += (v[j].x * wv.x + v[j].y * wv.y) + (v[j].z * wv.z + v[j].w * wv.w); }
            lg[c] = wave_sum(p); if ((c & 3) == 3) asm volatile("" ::: "memory"); }
        float gl[4];
#pragma unroll
        for (int i = 0; i < 4; ++i) gl[i] = lg[i] + a.in[21][i];
        int gs = 0; float gm = gl[0];
#pragma unroll
        for (int i = 1; i < 4; ++i) if (gl[i] > gm) { gm = gl[i]; gs = i; }
        float gsum = 0.f;
#pragma unroll
        for (int i = 0; i < 4; ++i) gsum += __expf(gl[i] - gm);
        const float gwt = 1.f / gsum;
        float el[4];
#pragma unroll
        for (int i = 0; i < 4; ++i) { const float e0 = lg[4 + i], e1 = lg[8 + i], e2 = lg[12 + i], e3 = lg[16 + i]; el[i] = (gs == 0 ? e0 : gs == 1 ? e1 : gs == 2 ? e2 : e3) + a.in[23][gs * 4 + i]; }
        int i1 = 0; float m1 = el[0];
#pragma unroll
        for (int i = 1; i < 4; ++i) if (el[i] > m1) { m1 = el[i]; i1 = i; }
        int i2 = -1; float m2 = -INFINITY;
#pragma unroll
        for (int i = 0; i < 4; ++i) if (i != i1 && el[i] > m2) { m2 = el[i]; i2 = i; }
        const float ex = __expf(m2 - m1), p1 = 1.f / (1.f + ex), p2 = ex * p1;
        if (F.lane == 0) {
            const unsigned slot = __hip_atomic_fetch_add((unsigned*)(F.ctl + CW_CNT + 64 * gs), 1u, RLX_AGENT);
            const size_t so = (size_t)gs * 16384 + slot;
            rowtab[so] = m;
            f32x4 cw; cw.x = (i1 == 0 ? p1 : i2 == 0 ? p2 : 0.f) * gwt; cw.y = (i1 == 1 ? p1 : i2 == 1 ? p2 : 0.f) * gwt; cw.z = (i1 == 2 ? p1 : i2 == 2 ? p2 : 0.f) * gwt; cw.w = (i1 == 3 ? p1 : i2 == 3 ? p2 : 0.f) * gwt;
            *(f32x4*)(CWt + so * 4) = cw;
        }
    }
}
struct MoeSched {
    int G, c, NB, nt0, nt1, nt2, nt3;
    __device__ bool next(int i, pg8::Unit& u) const {
        int L = i * G + c, g = 0, hb = 0;
        if (L >= nt0 * NB) { L -= nt0 * NB; hb += nt0; g = 1;
            if (L >= nt1 * NB) { L -= nt1 * NB; hb += nt1; g = 2;
                if (L >= nt2 * NB) { L -= nt2 * NB; hb += nt2; g = 3;
                    if (L >= nt3 * NB) return false; } } }
        const int pml = L / NB, pnl = L % NB;
        u.pm = hb + pml; u.pn = g * NB + pnl; u.aux = g * 16384 + pml * 256; return true;
    }
};
struct EpiUp {
    static constexpr bool PERM = true;
    unsigned char* ws;
    __device__ __forceinline__ void operator()(const pg8::f32x4 (&acc)[2][2][4][2], const pg8::Unit& u, int wr, int wc, int fr, int fq) const {
        int fr_ = fr, fq_ = fq; asm volatile("" : "+v"(fr_), "+v"(fq_));
        const int pnl = u.pn & 7, el = pnl >> 1, hf = pnl & 1;
        const float* CWt = (const float*)(ws + WS_CW); unsigned short* HID = (unsigned short*)(ws + WS_HID);
        const int lrow0 = wr * 64 + fr_, col0 = el * 256 + hf * 128 + wc * 32 + 8 * fq_;
#pragma unroll
        for (int ai = 0; ai < 2; ++ai)
#pragma unroll
            for (int m = 0; m < 4; ++m) { const int r = lrow0 + ai * 128 + m * 16; const float cw = CWt[(size_t)(u.aux + r) * 4 + el]; float hv[8];
#pragma unroll
                for (int n = 0; n < 2; ++n)
#pragma unroll
                    for (int e = 0; e < 4; ++e) { const float gt = acc[ai][0][m][n][e], up = acc[ai][1][m][n][e]; hv[4 * n + e] = gt / (1.f + __expf(-gt)) * up * cw; }
                pg8::u32x4 w; w.x = pg8::cvt_pk_bf16(hv[0], hv[1]); w.y = pg8::cvt_pk_bf16(hv[2], hv[3]); w.z = pg8::cvt_pk_bf16(hv[4], hv[5]); w.w = pg8::cvt_pk_bf16(hv[6], hv[7]);
                *(pg8::u32x4*)(HID + (size_t)(u.pm * 256 + r) * 1024 + col0) = w; }
    }
};
struct EpiDown {
    static constexpr bool PERM = false;
    unsigned char* ws; float* out;
    __device__ __forceinline__ void operator()(const pg8::f32x4 (&acc)[2][2][4][2], const pg8::Unit& u, int wr, int wc, int fr, int fq) const {
        int fr_ = fr, fq_ = fq; asm volatile("" : "+v"(fr_), "+v"(fq_));
        const int g = u.pn >> 2, pnl = u.pn & 3, n_g = (int)__hip_atomic_load((gu32*)(ws + WS_CTL) + CW_CNT + 64 * g, RLX_AGENT);
        const int* rowtab = (const int*)(ws + WS_CTL + CTL_ROWTAB);
        const int lrow0 = wr * 64 + fr_, col0 = pnl * 256 + wc * 32 + 4 * fq_, sl0 = u.aux - g * 16384;
#pragma unroll
        for (int ai = 0; ai < 2; ++ai)
#pragma unroll
            for (int m = 0; m < 4; ++m) { const int r = lrow0 + ai * 128 + m * 16;
                if (sl0 + r < n_g) { const int tok = rowtab[u.aux + r]; float* op = out + (size_t)tok * 1024 + col0;
#pragma unroll
                    for (int bj = 0; bj < 2; ++bj)
#pragma unroll
                        for (int n = 0; n < 2; ++n) { f32x4* p = (f32x4*)(op + bj * 128 + n * 16); *p = *p + acc[ai][bj][m][n]; } } }
    }
};

constexpr int MA_STRIDE = 528;
__device__ __forceinline__ unsigned pack_bf16x2(float lo, float hi) { return pg8::cvt_pk_bf16(lo, hi); }
__device__ __forceinline__ void mem_attn_unit(Frame& F, const Args& a, int u) {
    const int rt = u >> 2, hd = u & 3, b = rt >> 5, w = F.wave, r = F.lane & 31, hh = F.lane >> 5;
    const bf16* MEMK = (const bf16*)(F.ws + WS_MEMK); const bf16* MEMVT = (const bf16*)(F.ws + WS_MEMVT); bf16* MQ = (bf16*)(F.ws + WS_MQ);
    {
        const int c = F.tid & 31; float gn[8];
#pragma unroll
        for (int j = 0; j < 8; ++j) gn[j] = a.in[13][c * 8 + j] * a.in[12][c * 8 + j] * 0.0625f;
#pragma unroll 4
        for (int it = 0; it < 16; ++it) { const int m = (F.tid >> 5) + 16 * it;
            const v4u v = *(const GAS v4u*)(MEMK + (size_t)(b * 256 + m) * 1024 + hd * 256 + c * 8);
            float x[8]; x[0] = bf2f((unsigned short)(v.x & 0xffff)); x[1] = bf2f((unsigned short)(v.x >> 16)); x[2] = bf2f((unsigned short)(v.y & 0xffff)); x[3] = bf2f((unsigned short)(v.y >> 16));
            x[4] = bf2f((unsigned short)(v.z & 0xffff)); x[5] = bf2f((unsigned short)(v.z >> 16)); x[6] = bf2f((unsigned short)(v.w & 0xffff)); x[7] = bf2f((unsigned short)(v.w >> 16));
            float ss = 0.f;
#pragma unroll
            for (int j = 0; j < 8; ++j) ss += x[j] * x[j];
            ss += __shfl_xor(ss, 1); ss += __shfl_xor(ss, 2); ss += __shfl_xor(ss, 4); ss += __shfl_xor(ss, 8); ss += __shfl_xor(ss, 16);
            const float rk = 1.f / sqrtf(ss * (1.f / 256.f) + EPS);
            v4u o; o.x = pk2(x[0] * rk * gn[0], x[1] * rk * gn[1]); o.y = pk2(x[2] * rk * gn[2], x[3] * rk * gn[3]); o.z = pk2(x[4] * rk * gn[4], x[5] * rk * gn[5]); o.w = pk2(x[6] * rk * gn[6], x[7] * rk * gn[7]);
            *(LAS v4u*)(F.lds + m * MA_STRIDE + c * 16) = o; }
    }
    const size_t qrow = (size_t)(rt * 256 + 32 * w + r);
    bf16x8 qf[16]; float ss = 0.f;
#pragma unroll
    for (int s = 0; s < 16; ++s) { qf[s] = *(const GAS bf16x8*)(MQ + qrow * 1024 + hd * 256 + 16 * s + 8 * hh);
#pragma unroll
        for (int j = 0; j < 8; ++j) { const float x = bf2f((unsigned short)qf[s][j]); ss += x * x; } }
    ss += __shfl_xor(ss, 32);
    const float rq2 = 1.4426950408889634f / sqrtf(ss * (1.f / 256.f) + EPS);
    __syncthreads();
    bf16x8 pf[8][2]; float lsum = 0.f;
#pragma unroll
    for (int kt = 0; kt < 8; ++kt) { f32x16 c = (f32x16){};
#pragma unroll
        for (int s = 0; s < 16; ++s) { const bf16x8 af = *(const LAS bf16x8*)(F.lds + (32 * kt + r) * MA_STRIDE + 32 * s + 16 * hh);
            c = __builtin_amdgcn_mfma_f32_32x32x16_bf16(af, qf[s], c, 0, 0, 0); }
#pragma unroll
        for (int i = 0; i < 16; ++i) { c[i] = __builtin_amdgcn_exp2f(c[i] * rq2); lsum += c[i]; }
#pragma unroll
        for (int s2 = 0; s2 < 2; ++s2) { v4u pk; pk.x = pack_bf16x2(c[8 * s2 + 0], c[8 * s2 + 1]); pk.y = pack_bf16x2(c[8 * s2 + 2], c[8 * s2 + 3]); pk.z = pack_bf16x2(c[8 * s2 + 4], c[8 * s2 + 5]); pk.w = pack_bf16x2(c[8 * s2 + 6], c[8 * s2 + 7]);
            pf[kt][s2] = __builtin_bit_cast(bf16x8, pk); } }
    lsum += __shfl_xor(lsum, 32);
    const float rl = 1.f / lsum;
    __syncthreads();
#pragma unroll 4
    for (int it = 0; it < 16; ++it) { const int d = (F.tid >> 5) + 16 * it, c = F.tid & 31;
        *(LAS v4u*)(F.lds + d * MA_STRIDE + c * 16) = *(const GAS v4u*)(MEMVT + (size_t)(hd * 256 + d) * 512 + b * 256 + c * 8); }
    __syncthreads();
#pragma unroll 1
    for (int dt = 0; dt < 8; ++dt) { f32x16 o = (f32x16){};
#pragma unroll
        for (int kt = 0; kt < 8; ++kt)
#pragma unroll
            for (int s2 = 0; s2 < 2; ++s2) { const LAS unsigned char* vp = F.lds + (32 * dt + r) * MA_STRIDE + (32 * kt + 16 * s2 + 4 * hh) * 2;
                const v2u lo = *(const LAS v2u*)vp, hi = *(const LAS v2u*)(vp + 16); const v4u av = (v4u){lo.x, lo.y, hi.x, hi.y};
                o = __builtin_amdgcn_mfma_f32_32x32x16_bf16(__builtin_bit_cast(bf16x8, av), pf[kt][s2], o, 0, 0, 0); }
#pragma unroll
        for (int g4 = 0; g4 < 4; ++g4) { v2u st; st.x = pack_bf16x2(o[4 * g4 + 0] * rl, o[4 * g4 + 1] * rl); st.y = pack_bf16x2(o[4 * g4 + 2] * rl, o[4 * g4 + 3] * rl);
            *(GAS v2u*)(MQ + qrow * 1024 + hd * 256 + 32 * dt + 8 * g4 + 4 * hh) = st; } }
    __syncthreads();
}
__device__ __forceinline__ void dsa_k_prepass(Frame& F, const Args& a) {
    bf16* DKV = (bf16*)(F.ws + WS_DKV); const int c = F.lane & 15; float gn[8];
#pragma unroll
    for (int j = 0; j < 8; ++j) gn[j] = a.in[10][c * 8 + j] * a.in[9][c * 8 + j] * 0.08838834764831845f;
    for (int p = ((int)blockIdx.x * NTHREADS + F.tid) >> 4; p < M * 2; p += (F.G * NTHREADS) >> 4) { const int row = p >> 1, kvh = p & 1;
        GAS v4u* ptr = (GAS v4u*)(DKV + (size_t)row * 512 + kvh * 128 + c * 8); const v4u v = *ptr;
        float x[8]; x[0] = bf2f((unsigned short)(v.x & 0xffff)); x[1] = bf2f((unsigned short)(v.x >> 16)); x[2] = bf2f((unsigned short)(v.y & 0xffff)); x[3] = bf2f((unsigned short)(v.y >> 16));
        x[4] = bf2f((unsigned short)(v.z & 0xffff)); x[5] = bf2f((unsigned short)(v.z >> 16)); x[6] = bf2f((unsigned short)(v.w & 0xffff)); x[7] = bf2f((unsigned short)(v.w >> 16));
        float ss = 0.f;
#pragma unroll
        for (int j = 0; j < 8; ++j) ss += x[j] * x[j];
        ss += __shfl_xor(ss, 1); ss += __shfl_xor(ss, 2); ss += __shfl_xor(ss, 4); ss += __shfl_xor(ss, 8);
        const float rk = 1.f / sqrtf(ss * (1.f / 128.f) + EPS);
        v4u o; o.x = pk2(x[0] * rk * gn[0], x[1] * rk * gn[1]); o.y = pk2(x[2] * rk * gn[2], x[3] * rk * gn[3]); o.z = pk2(x[4] * rk * gn[4], x[5] * rk * gn[5]); o.w = pk2(x[6] * rk * gn[6], x[7] * rk * gn[7]);
        *ptr = o; }
}

constexpr int SL_HIST = 0, SL_SEL = 32768, SL_CS = 40960, SL_CI = 73728, SL_QST = 90112, SL_RN = 91136, SEL_CAP = 512;
typedef _Float16 h8 __attribute__((ext_vector_type(8)));
#define REOPAQUE_F(F) do { int t_ = threadIdx.x; asm volatile("" : "+v"(t_)); (F).tid = t_; (F).lane = t_ & 63; } while (0)
typedef _Float16 h2v __attribute__((ext_vector_type(2)));
__device__ __forceinline__ void sel_setup(Frame& F, const Args& a, int b, int t0, h8 (&af)[4][4], h2v (&sg)[4][8], bool write_rn) {
    const int w = F.wave, r = F.lane & 31, hh = F.lane >> 5;
    const _Float16* IQ = (const _Float16*)(F.ws + WS_IQ); const _Float16* SM = (const _Float16*)(F.ws + WS_SM);
    LAS float* RN = (LAS float*)(F.lds + SL_RN) + w * 128;
    const int ql = 2 * ((r >> 2) & 1) + (r >> 4), hd = (r & 3) + 4 * ((r >> 3) & 1);
    const float cidx = 0.04419417382415922f;
#pragma unroll
    for (int mt = 0; mt < 4; ++mt) { const size_t row = (size_t)(b * T + t0 + 4 * mt + ql);
        const float wv = (float)SM[row * 128 + 80 + hd] * cidx, wa = fabsf(wv) * (write_rn ? 1.f : ((const LAS float*)(F.lds + SL_QST))[64 + 4 * mt + ql]); float ssq = 0.f;
#pragma unroll
        for (int s = 0; s < 4; ++s) { const h8 v = *(const GAS h8*)(IQ + row * 512 + hd * 64 + 16 * s + 8 * hh); h8 o;
#pragma unroll
            for (int e = 0; e < 8; ++e) { const float x = (float)v[e] * wa * a.in[11][16 * s + 8 * hh + e]; o[e] = (_Float16)x; ssq += x * x; }
            af[mt][s] = o; }
        ssq += __shfl_xor(ssq, 32);
        if (write_rn && hh == 0) RN[(4 * mt + ql) * 8 + hd] = sqrtf(ssq);
#pragma unroll
        for (int i = 0; i < 16; ++i) { const int rr = (i & 3) + 8 * (i >> 2) + 4 * hh, q2 = 2 * ((rr >> 2) & 1) + (rr >> 4), h2 = (rr & 3) + 4 * ((rr >> 3) & 1);
            sg[mt][i >> 1][i & 1] = (float)SM[(size_t)(b * T + t0 + 4 * mt + q2) * 128 + 80 + h2] < 0.f ? (_Float16)-1.f : (_Float16)1.f; } }
}
template <int PASS>
__device__ __forceinline__ void sel_pass(Frame& F, const Args& a, int b, int t0, int nkt) {
    REOPAQUE_F(F);
    h8 af[4][4]; h2v sg[4][8]; sel_setup(F, a, b, t0, af, sg, false);
    const int w = F.wave, c = F.lane & 31, hh = F.lane >> 5;
    const _Float16* SM = (const _Float16*)(F.ws + WS_SM);
    LAS unsigned* QSTu = (LAS unsigned*)(F.lds + SL_QST);
    int thr[4][2];
#pragma unroll
    for (int mt = 0; mt < 4; ++mt)
#pragma unroll
        for (int ab = 0; ab < 2; ++ab) { const int q = 4 * mt + 2 * hh + ab; thr[mt][ab] = PASS == 2 ? (int)QSTu[16 + q] : 0; }
    for (int kt = w; kt < nkt; kt += NWAVES) {
        const int j = 32 * kt + c;
        h8 bf[4]; float ss = 0.f;
#pragma unroll
        for (int s = 0; s < 4; ++s) { bf[s] = *(const GAS h8*)(SM + (size_t)(b * T + j) * 128 + 16 + 16 * s + 8 * hh);
#pragma unroll
            for (int e = 0; e < 8; ++e) { const float x = (float)bf[s][e]; ss += x * x; } }
        ss += __shfl_xor(ss, 32);
        const float rk = 1.f / sqrtf(ss * (1.f / 64.f) + EPS);
        const bool edge = 32 * kt + 31 > t0;
#pragma unroll
        for (int mt = 0; mt < 4; ++mt) { f32x16 acc = (f32x16){};
#pragma unroll
            for (int s = 0; s < 4; ++s) acc = __builtin_amdgcn_mfma_f32_32x32x16_f16(af[mt][s], bf[s], acc, 0, 0, 0);
            float sa = 0.f, sb = 0.f;
#pragma unroll
            for (int i = 0; i < 8; ++i) { sa = fmaf(fmaxf(acc[i], 0.f), (float)sg[mt][i >> 1][i & 1], sa); sb = fmaf(fmaxf(acc[8 + i], 0.f), (float)sg[mt][4 + (i >> 1)][i & 1], sb); }
            sa *= rk; sb *= rk;
#pragma unroll
            for (int ab = 0; ab < 2; ++ab) { const float s = ab ? sb : sa; const int q = 4 * mt + 2 * hh + ab;
                const bool ok = !edge || j <= t0 + q;
                float x = s + 512.f; x = fminf(fmaxf(x, 0.f), 1023.f); const int bin = (int)x;
                if (PASS == 1) { if (ok) __hip_atomic_fetch_add((LAS unsigned*)(F.lds + SL_HIST + q * 2048 + (bin >> 1) * 4), 1u << ((bin & 1) * 16), __ATOMIC_RELAXED, __HIP_MEMORY_SCOPE_WORKGROUP); }
                else {
                    if (ok && bin > thr[mt][ab]) { const unsigned p = __hip_atomic_fetch_add((LAS unsigned*)(F.lds + SL_QST + (32 + q) * 4), 1u, __ATOMIC_RELAXED, __HIP_MEMORY_SCOPE_WORKGROUP); if (p < 256u) *(LAS unsigned short*)(F.lds + SL_SEL + q * 512 + p * 2) = (unsigned short)j; }
                    else if (ok && bin == thr[mt][ab]) { const unsigned p = __hip_atomic_fetch_add((LAS unsigned*)(F.lds + SL_QST + (48 + q) * 4), 1u, __ATOMIC_RELAXED, __HIP_MEMORY_SCOPE_WORKGROUP);
                        if (p < (unsigned)SEL_CAP) { *(LAS float*)(F.lds + SL_CS + q * (SEL_CAP * 4) + p * 4) = s; *(LAS unsigned short*)(F.lds + SL_CI + q * (SEL_CAP * 2) + p * 2) = (unsigned short)j; } }
                } }
            __builtin_amdgcn_sched_barrier(0); }
    }
}
__device__ __forceinline__ void sel_item(Frame& F, const Args& a, int item) {
    REOPAQUE_F(F);
    const int b = item & 1, t0 = (item >> 1) * 16, w = F.wave, r = F.lane & 31, hh = F.lane >> 5;
    unsigned short* IDX = (unsigned short*)(F.ws + WS_IDX);
    if (t0 + 15 < TOPK) {
#pragma unroll
        for (int qq = 0; qq < 2; ++qq) { const int t = t0 + 2 * w + qq; unsigned short* dst = IDX + (size_t)(b * T + t) * 256;
#pragma unroll
            for (int i = 0; i < 4; ++i) dst[F.lane * 4 + i] = (unsigned short)(F.lane * 4 + i); }
        return;
    }
    LAS float* QSTf = (LAS float*)(F.lds + SL_QST); LAS unsigned* QSTu = (LAS unsigned*)(F.lds + SL_QST); LAS float* RN = (LAS float*)(F.lds + SL_RN) + w * 128;
    for (int i = F.tid; i < 8192; i += NTHREADS) ((LAS unsigned*)(F.lds + SL_HIST))[i] = 0u;
    if (F.tid < 96) QSTu[F.tid] = 0u;
    {
        const _Float16* IQ = (const _Float16*)(F.ws + WS_IQ); const _Float16* SM = (const _Float16*)(F.ws + WS_SM);
        const int ql = 2 * ((r >> 2) & 1) + (r >> 4), hd = (r & 3) + 4 * ((r >> 3) & 1);
#pragma unroll 1
        for (int mt = 0; mt < 4; ++mt) { const size_t row = (size_t)(b * T + t0 + 4 * mt + ql);
            const float wa = fabsf((float)SM[row * 128 + 80 + hd]) * 0.04419417382415922f; float ssq = 0.f;
#pragma unroll
            for (int s = 0; s < 4; ++s) { const h8 v = *(const GAS h8*)(IQ + row * 512 + hd * 64 + 16 * s + 8 * hh);
#pragma unroll
                for (int e = 0; e < 8; ++e) { const float x = (float)(_Float16)((float)v[e] * wa * a.in[11][16 * s + 8 * hh + e]); ssq += x * x; } }
            ssq += __shfl_xor(ssq, 32);
            if (hh == 0) RN[(4 * mt + ql) * 8 + hd] = sqrtf(ssq); }
    }
    LDS_WAIT();
    if (w == 0 && F.lane < 16) { float bs = 0.f;
#pragma unroll
        for (int h = 0; h < 8; ++h) bs += RN[F.lane * 8 + h];
        QSTf[64 + F.lane] = 512.f / (8.0f * 1.001f * bs + 1e-20f); }
    __syncthreads();
    const int nkt = (t0 + 16 + 31) >> 5;
    sel_pass<1>(F, a, b, t0, nkt);
    __syncthreads();
#pragma unroll
    for (int qq = 0; qq < 2; ++qq) { const int q = 2 * w + qq; const LAS unsigned* hp = (const LAS unsigned*)(F.lds + SL_HIST + q * 2048 + F.lane * 32);
        unsigned hw[8]; unsigned tot = 0;
#pragma unroll
        for (int i = 0; i < 8; ++i) { hw[i] = hp[i]; tot += (hw[i] & 0xffffu) + (hw[i] >> 16); }
        unsigned suf = tot;
#pragma unroll
        for (int o = 1; o < 64; o <<= 1) { const unsigned v = __shfl_down(suf, o); if (F.lane + o < 64) suf += v; }
        const unsigned above_l = suf - tot;
        if (above_l < (unsigned)TOPK && suf >= (unsigned)TOPK) { unsigned run = above_l; int bsel = 16 * F.lane; unsigned ab = above_l; bool found = false;
#pragma unroll
            for (int i = 15; i >= 0; --i) { const unsigned hv = (i & 1) ? (hw[i >> 1] >> 16) : (hw[i >> 1] & 0xffffu);
                if (!found && run + hv >= (unsigned)TOPK) { found = true; bsel = 16 * F.lane + i; ab = run; }
                run += hv; }
            QSTu[16 + q] = (unsigned)bsel; QSTu[q] = (unsigned)TOPK - ab; QSTu[80 + q] = ab; } }
    __syncthreads();
    sel_pass<2>(F, a, b, t0, nkt);
    __syncthreads();
#pragma unroll 1
    for (int qq = 0; qq < 2; ++qq) { const int q = 2 * w + qq; const unsigned need = QSTu[q], above = QSTu[80 + q]; unsigned nc = QSTu[48 + q]; if (nc > (unsigned)SEL_CAP) nc = SEL_CAP;
        const LAS float* cs = (const LAS float*)(F.lds + SL_CS + q * (SEL_CAP * 4)); const LAS unsigned short* ci = (const LAS unsigned short*)(F.lds + SL_CI + q * (SEL_CAP * 2));
        for (unsigned i = F.lane; i < nc; i += 64) { const float si = cs[i]; const unsigned ii = ci[i]; unsigned rank = 0;
            for (unsigned k = 0; k < nc; ++k) { const float sk = cs[k]; const unsigned ik = ci[k]; rank += (sk > si || (sk == si && ik < ii)) ? 1u : 0u; }
            if (rank < need) *(LAS unsigned short*)(F.lds + SL_SEL + q * 512 + (above + rank) * 2) = (unsigned short)ii; }
        LDS_WAIT();
        unsigned short* dst = IDX + (size_t)(b * T + t0 + q) * 256;
        *(GAS v2u*)(dst + F.lane * 4) = *(const LAS v2u*)(F.lds + SL_SEL + q * 512 + F.lane * 8); }
    __syncthreads();
}
__device__ __forceinline__ void sel_phase(Frame& F, const Args& a) {
    for (int rd = 0;; ++rd) { const int idx = rd * F.G + ((rd & 1) ? F.G - 1 - (int)blockIdx.x : (int)blockIdx.x); if (idx >= 1024) break; sel_item(F, a, idx); }
}

constexpr int DA_WAVE_BYTES = 9728, DA_VL = 1024, DA_VSTRIDE = 272;
typedef short v4i16_t __attribute__((ext_vector_type(4)));
__device__ __forceinline__ void dsa_attn_query(Frame& F, int row) {
    const int b = row >> 13, t = row & (T - 1), cnt = t + 1 < TOPK ? t + 1 : TOPK, c = F.lane & 15, kg = F.lane >> 4;
    const unsigned short* IDX = (const unsigned short*)(F.ws + WS_IDX); bf16* DQ = (bf16*)(F.ws + WS_DQ); const bf16* DKV = (const bf16*)(F.ws + WS_DKV);
    LAS unsigned char* wl = F.lds + F.wave * DA_WAVE_BYTES; LAS unsigned short* IDXL = (LAS unsigned short*)wl; LAS unsigned char* VL = wl + DA_VL;
    *(LAS v2u*)(wl + F.lane * 8) = *(const GAS v2u*)(IDX + (size_t)row * 256 + F.lane * 4);
    bf16x8 qf[4]; float ss = 0.f;
#pragma unroll
    for (int s = 0; s < 4; ++s) { const v4u v = c < 8 ? *(const GAS v4u*)(DQ + (size_t)row * 1024 + c * 128 + 32 * s + 8 * kg) : (v4u){0u, 0u, 0u, 0u}; qf[s] = __builtin_bit_cast(bf16x8, v);
#pragma unroll
        for (int j = 0; j < 8; ++j) { const float x = bf2f((unsigned short)qf[s][j]); ss += x * x; } }
    ss += __shfl_xor(ss, 16); ss += __shfl_xor(ss, 32);
    const float rq2 = 1.4426950408889634f / sqrtf(ss * (1.f / 128.f) + EPS);
    f32x4 O0[8], O1[8];
#pragma unroll
    for (int d = 0; d < 8; ++d) { O0[d] = (f32x4){0.f, 0.f, 0.f, 0.f}; O1[d] = (f32x4){0.f, 0.f, 0.f, 0.f}; }
    float lsum = 0.f;
    LDS_WAIT();
#pragma unroll 1
    for (int ch = 0; ch < 8; ++ch) {
        float pv[8];
#pragma unroll
        for (int tau = 0; tau < 2; ++tau) { const int pos = 32 * ch + 16 * tau + c; const int key = pos < cnt ? (int)IDXL[pos] : 0;
            const bf16* kb = DKV + (size_t)(b * T + key) * 512 + 8 * kg;
            f32x4 C0 = (f32x4){0.f, 0.f, 0.f, 0.f}, C1 = C0;
#pragma unroll
            for (int s = 0; s < 4; ++s) { const bf16x8 k0 = *(const GAS bf16x8*)(kb + 32 * s), k1 = *(const GAS bf16x8*)(kb + 128 + 32 * s);
                C0 = __builtin_amdgcn_mfma_f32_16x16x32_bf16(k0, qf[s], C0, 0, 0, 0); C1 = __builtin_amdgcn_mfma_f32_16x16x32_bf16(k1, qf[s], C1, 0, 0, 0); }
#pragma unroll
            for (int i = 0; i < 4; ++i) { const float sv = c < 4 ? C0[i] : C1[i]; const bool ok = (32 * ch + 16 * tau + 4 * kg + i < cnt) && c < 8;
                const float p = ok ? __builtin_amdgcn_exp2f(sv * rq2) : 0.f; pv[4 * tau + i] = p; lsum += p; } }
        v4u pk; pk.x = pack_bf16x2(pv[0], pv[1]); pk.y = pack_bf16x2(pv[2], pv[3]); pk.z = pack_bf16x2(pv[4], pv[5]); pk.w = pack_bf16x2(pv[6], pv[7]);
        const bf16x8 pfr = __builtin_bit_cast(bf16x8, pk);
#pragma unroll
        for (int kvh = 0; kvh < 2; ++kvh) {
#pragma unroll
            for (int it = 0; it < 8; ++it) { const int rp = 4 * it + kg, pos = 32 * ch + rp; const int key = pos < cnt ? (int)IDXL[pos] : 0;
                *(LAS v4u*)(VL + rp * DA_VSTRIDE + c * 16) = *(const GAS v4u*)(DKV + (size_t)(b * T + key) * 512 + 256 + kvh * 128 + c * 8); }
            LDS_WAIT();
            const LAS unsigned char* vb = VL + (4 * kg + (c >> 2)) * DA_VSTRIDE + (c & 3) * 8;
#pragma unroll
            for (int dt = 0; dt < 8; ++dt) {
                const v4i16_t t0 = __builtin_amdgcn_ds_read_tr16_b64_v4i16((LAS v4i16_t*)(vb + dt * 32));
                const v4i16_t t1 = __builtin_amdgcn_ds_read_tr16_b64_v4i16((LAS v4i16_t*)(vb + 16 * DA_VSTRIDE + dt * 32));
                const bf16x8 vf = (bf16x8){t0[0], t0[1], t0[2], t0[3], t1[0], t1[1], t1[2], t1[3]};
                if (kvh == 0) O0[dt] = __builtin_amdgcn_mfma_f32_16x16x32_bf16(pfr, vf, O0[dt], 0, 0, 0);
                else O1[dt] = __builtin_amdgcn_mfma_f32_16x16x32_bf16(pfr, vf, O1[dt], 0, 0, 0); }
            LDS_WAIT();
        }
    }
    lsum += __shfl_xor(lsum, 16); lsum += __shfl_xor(lsum, 32);
    float rl[4];
#pragma unroll
    for (int i = 0; i < 4; ++i) rl[i] = 1.f / __shfl(lsum, (4 * kg + i) & 7);
    if (kg < 2) {
#pragma unroll
        for (int dt = 0; dt < 8; ++dt)
#pragma unroll
            for (int i = 0; i < 4; ++i) { const float v = (kg == 0 ? O0[dt][i] : O1[dt][i]) * rl[i]; DQ[(size_t)row * 1024 + (4 * kg + i) * 128 + 16 * dt + c] = (bf16)f2bf(v); }
    }
}
__device__ __forceinline__ void dsa_attn_phase(Frame& F) {
    for (int gid = F.vcu * NWAVES + F.wave; gid < M / 8; gid += F.G * NWAVES)
#pragma unroll 1
        for (int i = 0; i < 8; ++i) dsa_attn_query(F, gid * 8 + i);
}

constexpr int N_PHASES = 10;
__global__ void __launch_bounds__(NTHREADS, 2) mk_fwd(Args args) {
    extern __shared__ __attribute__((aligned(16))) unsigned char lds[];
    Frame F;
    F.lds = (LAS unsigned char*)lds;
    F.MISC = (volatile LAS unsigned*)(F.lds + MISC_OFF);
    F.tid = threadIdx.x; F.lane = F.tid & 63; F.wave = __builtin_amdgcn_readfirstlane(F.tid >> 6);
    F.G = gridDim.x; { const int bx = blockIdx.x; F.vcu = (F.G % 8 == 0) ? (bx % 8) * (F.G / 8) + bx / 8 : bx; }
    F.ws = args.ws; F.outb = (unsigned char*)args.out;
    F.ctl = (gu32*)(args.ws + WS_CTL);
    for (int u = F.tid; u < (LDS_BYTES - LDSCTL_OFF) / 4; u += NTHREADS) ((LAS unsigned*)(F.lds + LDSCTL_OFF))[u] = 0u;
    __syncthreads();
    XcdBarrier bar; bar.bar = (unsigned*)(F.ctl + CW_BAR); bar.x = 0; bar.st = nullptr;
    if (MK_N_LAUNCHES == 1) bar = xcd_barrier_post((unsigned*)(F.ctl + CW_BAR), F.MISC + 8);
    const int lo = args.ph_lo, hi = args.ph_hi;
#ifndef PH_MASK
#define PH_MASK 0xffffffffu
#endif
#define IN(k) (((PH_MASK >> (k)) & 1u) && lo <= (k) && (k) < hi)
#define REOPAQUE() do { int t_ = threadIdx.x; asm volatile("" : "+v"(t_)); F.tid = t_; F.lane = t_ & 63; } while (0)
#define SEAM(k) do { if (IN(k) && IN((k) + 1)) xcd_barrier(bar); { int t_ = threadIdx.x; asm volatile("" : "+v"(t_)); F.tid = t_; F.lane = t_ & 63; } } while (0)

    if (IN(0)) { p0_prologue(F, args); build_router_weights(F, args); }
    SEAM(0);
    if (IN(1)) {
        {
            const int c = (int)blockIdx.x;
            if (c >= 64 && c < 72) { pg8::Gemm g{(const bf16*)(F.ws + WS_MEMN), (const bf16*)(F.outb + OUT_WKVT), D}; OneUnit S{c - 64, 4, 0};
                EpiPlain E{(unsigned short*)(F.ws + WS_MEMK), 1024}; pg8::gemm_phase<EpiPlain, OneUnit, true>(F.lds, g, S, E); }
            else if (c >= 72 && c < 80) { pg8::Gemm g{(const bf16*)(F.outb + OUT_WKVT) + (size_t)1024 * D, (const bf16*)(F.ws + WS_MEMN), D}; OneUnit S{c - 72, 2, 0};
                EpiPlain E{(unsigned short*)(F.ws + WS_MEMVT), 512}; pg8::gemm_phase<EpiPlain, OneUnit, true>(F.lds, g, S, E); }
        }
        pg8::Gemm g{(const bf16*)(F.ws + WS_XN), (const bf16*)(F.outb + OUT_W1T), D}; pg8::StaticOrder S; S.init(M, N1, F.G, (int)blockIdx.x);
        EpiG1 E{F.ws}; pg8::gemm_phase<EpiG1, pg8::StaticOrder, true>(F.lds, g, S, E);
    }
    SEAM(1);
    if (IN(2)) {
        for (int it = (int)blockIdx.x; it < 1024; it += F.G) gla_b1_item(F, args, it);
        REOPAQUE();
        for (int u = (int)blockIdx.x; u < 256; u += F.G) mem_attn_unit(F, args, u);
        REOPAQUE();
        dsa_k_prepass(F, args);
        __syncthreads(); REOPAQUE(); sel_phase(F, args);
    }
    SEAM(2);
    if (IN(3)) { gla_b2_scan(F); REOPAQUE(); dsa_attn_phase(F); }
    SEAM(3);
    if (IN(4)) {
        for (int it = (int)blockIdx.x; it < 1024; it += F.G) gla_b3_item(F, args, it);
        conv_mid_weights(F, args);
    }
    SEAM(4);
    if (IN(5)) {
        conv_moe_weights(F, args); __syncthreads();
        pg8::Gemm g{(const bf16*)F.ws, (const bf16*)F.ws, D}; MergeSched S{F.G, (int)blockIdx.x};
        EpiMerge E{F.ws, args.out, args.in[14], (int)blockIdx.x}; pg8::gemm_phase<EpiMerge, MergeSched, true>(F.lds, g, S, E);
    }
    SEAM(5);
    if (IN(6)) {
        pg8::Gemm g{(const bf16*)F.ws, (const bf16*)F.ws, D}; OutSched S{F.G, (int)blockIdx.x};
        EpiResid E{args.in[0], args.out}; pg8::gemm_phase<EpiResid, OutSched, true>(F.lds, g, S, E);
    }
    SEAM(6);
    if (IN(7)) { router_phase(F, args); }
    SEAM(7);
    if (IN(8)) {
        const int n0 = (int)__hip_atomic_load(F.ctl + CW_CNT + 0, RLX_AGENT), n1 = (int)__hip_atomic_load(F.ctl + CW_CNT + 64, RLX_AGENT), n2 = (int)__hip_atomic_load(F.ctl + CW_CNT + 128, RLX_AGENT), n3 = (int)__hip_atomic_load(F.ctl + CW_CNT + 192, RLX_AGENT);
        MoeSched S{F.G, (int)blockIdx.x, 8, (n0 + 255) >> 8, (n1 + 255) >> 8, (n2 + 255) >> 8, (n3 + 255) >> 8};
        pg8::Gemm g{(const bf16*)(F.ws + WS_H2), (const bf16*)(F.ws + WS_MOEW), D};
        EpiUp E{F.ws}; pg8::gemm_phase<EpiUp, MoeSched, true, true>(F.lds, g, S, E, (const int*)(F.ws + WS_CTL + CTL_ROWTAB));
    }
    SEAM(8);
    if (IN(9)) {
        const int n0 = (int)__hip_atomic_load(F.ctl + CW_CNT + 0, RLX_AGENT), n1 = (int)__hip_atomic_load(F.ctl + CW_CNT + 64, RLX_AGENT), n2 = (int)__hip_atomic_load(F.ctl + CW_CNT + 128, RLX_AGENT), n3 = (int)__hip_atomic_load(F.ctl + CW_CNT + 192, RLX_AGENT);
        MoeSched S{F.G, (int)blockIdx.x, 4, (n0 + 255) >> 8, (n1 + 255) >> 8, (n2 + 255) >> 8, (n3 + 255) >> 8}; EpiDown E{F.ws, args.out};
        pg8::Gemm g{(const bf16*)(F.ws + WS_HID), (const bf16*)(F.ws + WS_MOEW + 16 * MiB), D};
        pg8::gemm_phase<EpiDown, MoeSched, true>(F.lds, g, S, E);
    }
#undef IN
#undef SEAM
}

extern "C" void kernel_launch(void* const* d_in, const int* in_sizes, int n_in, void* d_out, int out_size, void* d_ws, size_t ws_size, hipStream_t stream) {
    static int grid = 0;
    if (grid == 0) {
        if (n_in != 27 || in_sizes[0] != M * D || out_size != M * D || ws_size < WS_END) { fprintf(stderr, "kernel_launch: unexpected shapes (n_in %d, in0 %d, out %d, ws %zu); nothing launched\n", n_in, n_in > 0 ? in_sizes[0] : -1, out_size, ws_size); grid = -1; return; }
        int dev = 0, cus = 0, per_cu = 0;
        if (hipGetDevice(&dev) != hipSuccess || hipDeviceGetAttribute(&cus, hipDeviceAttributeMultiprocessorCount, dev) != hipSuccess) { grid = -1; return; }
        if (hipFuncSetAttribute((const void*)mk_fwd, hipFuncAttributeMaxDynamicSharedMemorySize, LDS_BYTES) != hipSuccess) { fprintf(stderr, "kernel_launch: hipFuncSetAttribute failed\n"); grid = -1; return; }
        if (hipOccupancyMaxActiveBlocksPerMultiprocessor(&per_cu, (const void*)mk_fwd, NTHREADS, LDS_BYTES) != hipSuccess || per_cu < 1) { fprintf(stderr, "kernel_launch: occupancy query says %d blocks per CU; nothing launched\n", per_cu); (void)hipGetLastError(); grid = -1; return; }
        grid = cus;
    }
    if (grid < 0) return;
    (void)hipMemsetAsync((char*)d_ws + WS_CTL, 0, CTL_ZERO_BYTES, stream);
    Args a{};
    for (int i = 0; i < 27; ++i) a.in[i] = (const float*)d_in[i];
    a.out = (float*)d_out; a.ws = (unsigned char*)d_ws;
#if MK_N_LAUNCHES == 1
    a.ph_lo = 0; a.ph_hi = N_PHASES;
    hipLaunchKernelGGL(mk_fwd, dim3(grid), dim3(NTHREADS), LDS_BYTES, stream, a);
#else
    for (int p = 0; p < N_PHASES; ++p) { a.ph_lo = p; a.ph_hi = p + 1; hipLaunchKernelGGL(mk_fwd, dim3(grid), dim3(NTHREADS), LDS_BYTES, stream, a); }
#endif
}
```
